# Optimizing an MI355X kernel written in HIP

```python
import jax, jax.numpy as jnp
from jax import lax
import numpy as np


D_MODEL = 1024
BATCH = 8
SEQ = 4096
DEPTH = 4
DEC_BATCH = 4
DEC_SEQ = 4096
PAST_LEN = 128

GRID_W = 64
N_EVEN = (DEPTH + 1) // 2
N_ODD = DEPTH // 2
EPS = 1e-6

POOL_WIDTH = D_MODEL // 2
POOL_WINDOWS = (2, 4, 8, 16)
POOL_GROUPS = len(POOL_WINDOWS)
POOL_GC = POOL_WIDTH // POOL_GROUPS

HEAD_DIM = 64
N_Q_HEADS = (D_MODEL // 2) // HEAD_DIM
N_KV_HEADS = 2
Q_PER_KV = N_Q_HEADS // N_KV_HEADS
ATTN_WIDTH = N_Q_HEADS * HEAD_DIM
KV_WIDTH = N_KV_HEADS * HEAD_DIM
ROPE_HALF = HEAD_DIM // 2
ROPE_FREQ = ROPE_HALF // 2
ROPE_THETA = 10000.0
Q_BLOCK = 128

EVEN_SIZES = (POOL_WIDTH, POOL_WIDTH, ATTN_WIDTH, KV_WIDTH, KV_WIDTH, ATTN_WIDTH)
EVEN_IN = sum(EVEN_SIZES)
EVEN_SPLITS = tuple(int(s) for s in np.cumsum(EVEN_SIZES)[:-1])
EVEN_MIX = POOL_WIDTH + ATTN_WIDTH

SGU_WIDTH = D_MODEL
SGU_GROUPS = 8
SGU_GC = SGU_WIDTH // SGU_GROUPS
CHUNK = 128
ODD_IN = 3 * SGU_WIDTH

kernel_name = 'hybrid_pool_axialgqa_gmlp_encoder'


def rms_norm(x, g):
    xf = x.astype(jnp.float32)
    y = xf * lax.rsqrt(jnp.mean(xf * xf, axis=-1, keepdims=True) + EPS)
    return (y * g.astype(jnp.float32)).astype(x.dtype)


def rope_tables(L):
    rows_n = L // GRID_W
    row = jnp.repeat(jnp.arange(rows_n), GRID_W).astype(jnp.float32)
    col = jnp.tile(jnp.arange(GRID_W), rows_n).astype(jnp.float32)
    inv = 1.0 / (ROPE_THETA ** (jnp.arange(ROPE_FREQ, dtype=jnp.float32) / ROPE_FREQ))
    ang_r = row[:, None] * inv[None, :]
    ang_c = col[:, None] * inv[None, :]
    return (jnp.cos(ang_r), jnp.sin(ang_r), jnp.cos(ang_c), jnp.sin(ang_c))


def rope_1d(x, cos, sin):
    x1, x2 = x[..., :ROPE_FREQ], x[..., ROPE_FREQ:]
    return jnp.concatenate([x1 * cos - x2 * sin, x2 * cos + x1 * sin], axis=-1)


def rope_2d(x, tables):
    cos_r, sin_r, cos_c, sin_c = tables
    xf = x.astype(jnp.float32)
    xr = rope_1d(xf[..., :ROPE_HALF], cos_r[:, None, :], sin_r[:, None, :])
    xc = rope_1d(xf[..., ROPE_HALF:], cos_c[:, None, :], sin_c[:, None, :])
    return jnp.concatenate([xr, xc], axis=-1).astype(x.dtype)


def pool_mixer(u, pool_w, pool_scale):
    B, L, _ = u.shape
    uf = u.astype(jnp.float32)
    cs = jnp.concatenate([jnp.zeros((B, 1, POOL_WIDTH), jnp.float32), jnp.cumsum(uf, axis=1)], axis=1)
    t = jnp.arange(L)
    means = []
    for g, w in enumerate(POOL_WINDOWS):
        lo = jnp.clip(t - w // 2, 0, L)
        hi = jnp.clip(t + w // 2, 0, L)
        cnt = (hi - lo).astype(jnp.float32)
        csg = cs[..., g * POOL_GC:(g + 1) * POOL_GC]
        means.append((jnp.take(csg, hi, axis=1) - jnp.take(csg, lo, axis=1)) / cnt[None, :, None])
    pooled = jnp.stack(means, axis=2)
    diff = (pooled - uf.reshape(B, L, POOL_GROUPS, POOL_GC)).astype(u.dtype)
    mixed = jnp.einsum('blgc,gcd->blgd', diff, pool_w).reshape(B, L, POOL_WIDTH)
    return mixed * pool_scale


def axial_gqa(q, k, v, q_g, k_g, tables):
    B, L, _ = q.shape
    nb = L // Q_BLOCK
    q = rope_2d(rms_norm(q.reshape(B, L, N_Q_HEADS, HEAD_DIM), q_g), tables)
    k = rope_2d(rms_norm(k.reshape(B, L, N_KV_HEADS, HEAD_DIM), k_g), tables)
    v = v.reshape(B, L, N_KV_HEADS, HEAD_DIM)
    qb = q.reshape(B, nb, Q_BLOCK, N_KV_HEADS, Q_PER_KV, HEAD_DIM).transpose(1, 0, 2, 3, 4, 5)
    scale = HEAD_DIM ** -0.5

    def block(q_blk):
        s = jnp.einsum('bqkgd,bskd->bkgqs', q_blk, k, preferred_element_type=jnp.float32) * scale
        p = jax.nn.softmax(s, axis=-1).astype(v.dtype)
        return jnp.einsum('bkgqs,bskd->bqkgd', p, v)

    o = lax.map(block, qb)
    return o.transpose(1, 0, 2, 3, 4, 5).reshape(B, L, ATTN_WIDTH)


def even_layer(x, norm_g, w_in, pool_w, pool_scale, q_g, k_g, w_out, tables):
    h = rms_norm(x, norm_g)
    p = h @ w_in
    pu, pz, q, k, v, az = jnp.split(p, EVEN_SPLITS, axis=-1)
    a_out = pool_mixer(pu, pool_w, pool_scale) * jax.nn.silu(pz)
    b_out = axial_gqa(q, k, v, q_g, k_g, tables) * jax.nn.silu(az)
    return x + jnp.concatenate([a_out, b_out], axis=-1) @ w_out


def odd_layer(x, norm_g, w_in, sgu_g, w_s, b_s, w_out):
    B, L, _ = x.shape
    h = rms_norm(x, norm_g)
    u, vv, z = jnp.split(h @ w_in, 3, axis=-1)
    u = jax.nn.gelu(u, approximate=False)
    vv = rms_norm(jax.nn.gelu(vv, approximate=False), sgu_g)
    vc = vv.reshape(B, L // CHUNK, CHUNK, SGU_GROUPS, SGU_GC)
    sv = jnp.einsum('hpq,bnqhc->bnphc', w_s, vc) + b_s.T[None, None, :, :, None]
    y = u * sv.reshape(B, L, SGU_WIDTH) * jax.nn.silu(z)
    return x + y @ w_out


def trunk(x, norm_e, w_in_e, pool_w, pool_scale, q_norm, k_norm, w_out_e,
          norm_o, w_in_o, sgu_norm, w_s, b_s, w_out_o):
    tables = rope_tables(x.shape[1])
    for i in range(DEPTH):
        j = i // 2
        if i % 2 == 0:
            x = even_layer(x, norm_e[j], w_in_e[j], pool_w[j], pool_scale[j], q_norm[j], k_norm[j], w_out_e[j], tables)
        else:
            x = odd_layer(x, norm_o[j], w_in_o[j], sgu_norm[j], w_s[j], b_s[j], w_out_o[j])
    return x


def setup_inputs(seed: int = 0) -> dict:
    key = jax.random.key(seed)
    ks = jax.random.split(key, 16)
    f32 = jnp.float32
    nrm = lambda k, shape, s: jax.random.normal(k, shape, f32) * s
    return {
        'x_prompt': jax.random.normal(ks[0], (BATCH, SEQ, D_MODEL), f32),
        'x_sample': jax.random.normal(ks[1], (DEC_BATCH, DEC_SEQ, D_MODEL), f32),
        'norm_e': 1.0 + nrm(ks[2], (N_EVEN, D_MODEL), 0.02),
        'w_in_e': nrm(ks[3], (N_EVEN, D_MODEL, EVEN_IN), D_MODEL ** -0.5),
        'pool_w': nrm(ks[4], (N_EVEN, POOL_GROUPS, POOL_GC, POOL_GC), POOL_GC ** -0.5),
        'pool_scale': 1.0 + nrm(ks[5], (N_EVEN, POOL_WIDTH), 0.02),
        'q_norm': 1.0 + nrm(ks[6], (N_EVEN, HEAD_DIM), 0.02),
        'k_norm': 1.0 + nrm(ks[7], (N_EVEN, HEAD_DIM), 0.02),
        'w_out_e': nrm(ks[8], (N_EVEN, EVEN_MIX, D_MODEL), EVEN_MIX ** -0.5),
        'norm_o': 1.0 + nrm(ks[9], (N_ODD, D_MODEL), 0.02),
        'w_in_o': nrm(ks[10], (N_ODD, D_MODEL, ODD_IN), D_MODEL ** -0.5),
        'sgu_norm': 1.0 + nrm(ks[11], (N_ODD, SGU_WIDTH), 0.02),
        'w_s': nrm(ks[12], (N_ODD, SGU_GROUPS, CHUNK, CHUNK), CHUNK ** -0.5),
        'b_s': 1.0 + nrm(ks[13], (N_ODD, SGU_GROUPS, CHUNK), 0.02),
        'w_out_o': nrm(ks[14], (N_ODD, SGU_WIDTH, D_MODEL), SGU_WIDTH ** -0.5),
    }


def reference(x_prompt, x_sample, norm_e, w_in_e, pool_w, pool_scale, q_norm, k_norm, w_out_e,
              norm_o, w_in_o, sgu_norm, w_s, b_s, w_out_o):
    y_prompt = trunk(x_prompt, norm_e, w_in_e, pool_w, pool_scale, q_norm, k_norm, w_out_e,
                     norm_o, w_in_o, sgu_norm, w_s, b_s, w_out_o)
    y_sample = trunk(x_sample, norm_e, w_in_e, pool_w, pool_scale, q_norm, k_norm, w_out_e,
                     norm_o, w_in_o, sgu_norm, w_s, b_s, w_out_o)
    return (y_prompt, y_sample)
```

```cpp
#include <hip/hip_runtime.h>
#include <hip/hip_cooperative_groups.h>
#include <cstdio>
#include <cstdint>
namespace cg = cooperative_groups;

#define LAS __attribute__((address_space(3)))
typedef unsigned short bf16_t;
typedef short bf16x8 __attribute__((ext_vector_type(8)));
typedef short s16x4 __attribute__((ext_vector_type(4)));
typedef float f32x2 __attribute__((ext_vector_type(2)));
typedef float f32x4 __attribute__((ext_vector_type(4)));
typedef float f32x16 __attribute__((ext_vector_type(16)));
typedef unsigned u32x2 __attribute__((ext_vector_type(2)));
typedef unsigned u32x4 __attribute__((ext_vector_type(4)));

#ifndef N_LAUNCH_MODE
#define N_LAUNCH_MODE 1
#endif

constexpr int DM = 1024, SEQ = 4096, NSEQ = 12, MTOK = NSEQ * SEQ, MPROMPT = 8 * SEQ;
constexpr int EVEN_IN = 2304, ODD_IN = 3072;
constexpr float EPS = 1e-6f;
constexpr float C2 = 0.125f * 1.4426950408889634f;
constexpr int NPHASE = 17;

constexpr size_t WS_WINE = 0;
constexpr size_t WS_WOUTE = WS_WINE + 2ull * 2304 * 1024 * 2;
constexpr size_t WS_WINO = WS_WOUTE + 2ull * 1024 * 1024 * 2;
constexpr size_t WS_WOUTO = WS_WINO + 2ull * 3072 * 1024 * 2;
constexpr size_t WS_POOLW = WS_WOUTO + 2ull * 1024 * 1024 * 2;
constexpr size_t WS_WSB = WS_POOLW + 2ull * 4 * 128 * 128 * 2;
constexpr size_t WS_ROPE = WS_WSB + 2ull * 8 * 128 * 128 * 2;
constexpr size_t WS_BAR = WS_ROPE + 8192;
constexpr size_t WS_SS = 32ull << 20;
constexpr size_t WS_SSV = WS_SS + (size_t)MTOK * 16 * 4;
constexpr size_t WS_XB = 40ull << 20;
constexpr size_t WS_P = WS_XB + (size_t)MTOK * 1024 * 2;
constexpr size_t WS_END = WS_P + (size_t)MTOK * 3072 * 2;
static_assert(WS_BAR + 16384 <= WS_SS && WS_SSV + (size_t)MTOK * 64 <= WS_XB, "ws map");

constexpr int LDS_BYTES = 159760;
constexpr int BARW_OFF = 159744;
constexpr int XL_OFF = 131072;
constexpr int ROPE_OFF = 139264;
constexpr int RST_OFF = 147456;

__device__ __forceinline__ unsigned cvt_pk_bf16(float lo, float hi) { unsigned r; asm volatile("v_cvt_pk_bf16_f32 %0, %1, %2" : "=v"(r) : "v"(lo), "v"(hi)); return r; }
__device__ __forceinline__ float bflo(unsigned w) { return __uint_as_float(w << 16); }
__device__ __forceinline__ float bfhi(unsigned w) { return __uint_as_float(w & 0xffff0000u); }
__device__ __forceinline__ float silu_f(float v) { return v * __builtin_amdgcn_rcpf(1.f + __builtin_amdgcn_exp2f(-1.4426950408889634f * v)); }
__device__ __forceinline__ float wave_sum(float v) {
#pragma unroll
    for (int o = 1; o < 64; o <<= 1) v += __shfl_xor(v, o);
    return v;
}
#define LDS_WAIT() asm volatile("s_waitcnt lgkmcnt(0)" ::: "memory")
__device__ __forceinline__ f32x2 gelu_pk(f32x2 v) {
    const f32x2 av = __builtin_elementwise_abs(v), d = av * 0.2316418882f + 1.0f;
    f32x2 t; t.x = __builtin_amdgcn_rcpf(d.x); t.y = __builtin_amdgcn_rcpf(d.y);
    f32x2 q = t * 0.5307027145f + (-0.7265760135f); q = q * t + 0.7107068705f; q = q * t + (-0.142248368f); q = q * t + 0.127414796f; q = q * t;
    const f32x2 s = (v * v) * (-0.72134752044f);
    f32x2 e; e.x = __builtin_amdgcn_exp2f(s.x); e.y = __builtin_amdgcn_exp2f(s.y);
    const f32x2 m = av * (q * e);
    f32x2 o; o.x = __builtin_fmaxf(v.x, 0.f) - m.x; o.y = __builtin_fmaxf(v.y, 0.f) - m.y; return o;
}
__device__ __forceinline__ f32x4 gelu4(f32x4 v) { f32x2 a = gelu_pk((f32x2){v[0], v[1]}), b = gelu_pk((f32x2){v[2], v[3]}); return (f32x4){a.x, a.y, b.x, b.y}; }
__device__ __forceinline__ f32x2 silu_pk(f32x2 v) {
    const f32x2 t = v * (-1.4426950408889634f);
    f32x2 e; e.x = __builtin_amdgcn_exp2f(t.x); e.y = __builtin_amdgcn_exp2f(t.y);
    const f32x2 d = e + 1.0f;
    f32x2 r; r.x = __builtin_amdgcn_rcpf(d.x); r.y = __builtin_amdgcn_rcpf(d.y);
    return v * r;
}
__device__ __forceinline__ f32x4 silu4(f32x4 v) { const f32x2 a = silu_pk((f32x2){v[0], v[1]}), b = silu_pk((f32x2){v[2], v[3]}); return (f32x4){a.x, a.y, b.x, b.y}; }

__device__ __forceinline__ u32x4 pack8(f32x4 a, f32x4 b) { u32x4 w; w.x = cvt_pk_bf16(a[0], a[1]); w.y = cvt_pk_bf16(a[2], a[3]); w.z = cvt_pk_bf16(b[0], b[1]); w.w = cvt_pk_bf16(b[2], b[3]); return w; }
__device__ __forceinline__ float sq4(f32x4 a) { return (a[0] * a[0] + a[1] * a[1]) + (a[2] * a[2] + a[3] * a[3]); }
__device__ __forceinline__ float fq_sum(float s) {
    const auto a = __builtin_amdgcn_permlane16_swap(__float_as_uint(s), __float_as_uint(s), false, false);
    const float t = __uint_as_float(a[0]) + __uint_as_float(a[1]);
    const auto b = __builtin_amdgcn_permlane32_swap(__float_as_uint(t), __float_as_uint(t), false, false);
    return __uint_as_float(b[0]) + __uint_as_float(b[1]);
}
__device__ __forceinline__ float xor32(float v, bool lo) {
    const auto a = __builtin_amdgcn_permlane32_swap(__float_as_uint(v), __float_as_uint(v), false, false);
    return __uint_as_float(lo ? a[1] : a[0]);
}
__device__ __forceinline__ float row_rstd(const float* ss, int row, int fq) {
    const f32x4 p = *(const f32x4*)(ss + (size_t)row * 16 + 4 * fq);
    const float s = fq_sum((p[0] + p[1]) + (p[2] + p[3]));
    return __builtin_amdgcn_rsqf(s * (1.0f / 1024.0f) + EPS);
}

__device__ __forceinline__ void store_rows64(LAS unsigned char* st, bf16_t* base, size_t pitch, u32x4 val, int fr, int fq, int lane) {
    *(LAS u32x4*)(st + fr * 80 + fq * 16) = val;
    const u32x4 t = *(const LAS u32x4*)(st + (lane >> 2) * 80 + (lane & 3) * 16);
    *(u32x4*)(base + (size_t)(lane >> 2) * pitch + (lane & 3) * 8) = t;
}
namespace pg8 {
constexpr int BM = 256, BK = 64, HALF = 128, HTB = HALF * BK * 2, STAGE_BYTES = 8 * HTB, NXCD = 8, WGM = 8;
__host__ __device__ __forceinline__ int lds_byte(int r, int c) { const int st = (r >> 4) * 2 + (c >> 5), rr = r & 15, cc = c & 31, ob = rr * 64 + cc * 2; return st * 1024 + (ob ^ (((ob >> 9) & 1) << 5)); }
__host__ __device__ __forceinline__ void stage_rc(int b, int& R, int& C) { const int st = b / 1024, sb = b % 1024, swz = sb ^ (((sb >> 9) & 1) << 5); R = (st >> 1) * 16 + swz / 64; C = (st & 1) * 32 + (swz % 64) / 2; }
__host__ __device__ __forceinline__ int perm32(int rho) { const int n = rho >> 4, i = rho & 15; return 8 * (i >> 2) + 4 * n + (i & 3); }

struct Unit { int pm, pn; };
struct Gemm { const bf16_t* A; const bf16_t* Bt; int M, N, K, lda, xtra; };

struct StaticOrder {
    int nM, nN, nwg, G, c;
    __host__ __device__ void init(int M, int N, int G_, int c_) { nM = M / BM; nN = N / BM; nwg = nM * nN; G = G_; c = c_; }
    __host__ __device__ bool next(int i, Unit& u) const {
        const long L = (long)i * G + c; if (L >= nwg) return false;
        int wgid = (int)L; { const int q = nwg / NXCD, r = nwg % NXCD, xcd = wgid % NXCD, off = wgid / NXCD; wgid = (xcd < r ? xcd * (q + 1) : r * (q + 1) + (xcd - r) * q) + off; }
        const int nig = WGM * nN, gid = wgid / nig, fm = gid * WGM, gsz = (nM - fm) < WGM ? (nM - fm) : WGM;
        u.pm = fm + ((wgid % nig) % gsz); u.pn = (wgid % nig) / gsz; return true;
    }
};

template <class Epi>
__device__ __forceinline__ void gemm_phase(LAS unsigned char* lds, const Gemm g, const StaticOrder& S, const Epi& E, const int tid) {
    const int wid = __builtin_amdgcn_readfirstlane(tid >> 6), lane = tid & 63, wr = wid >> 2, wc = wid & 3, fr = lane & 15, fq = lane >> 4;
    const int K = g.K, nt = K / BK, lda = g.lda;
    unsigned voffA[2], voffB[2];
#pragma unroll
    for (int i = 0; i < 2; ++i) { int R, C; stage_rc(tid * 16 + i * 8192, R, C); const int Rb = (R & ~31) + perm32(R & 31);
        voffA[i] = (unsigned)(R * lda + C) * 2u; voffB[i] = (unsigned)(Rb * K + C) * 2u; }
    const size_t kstep = (size_t)(BK * 2);
    const size_t hstepA = (size_t)HALF * lda * 2, tstepA = 2 * hstepA;
    const size_t hstepB = (size_t)HALF * K * 2, tstepB = 2 * hstepB;
    const size_t xtra = (size_t)g.xtra;
    const unsigned ldsw = (unsigned)wid * 1024u;
    const int aoff = lds_byte(wr * 64 + fr, fq * 8), boff = lds_byte(wc * 32 + fr, fq * 8);
#define PG8_SA(b, h) (((b) * 2 + (h)) * HTB)
#define PG8_SB(b, h) ((4 + (b) * 2 + (h)) * HTB)
#define PG8_STAGE(bufoff, gbase, voff) do { _Pragma("unroll") for (int _i = 0; _i < 2; ++_i) \
        __builtin_amdgcn_global_load_lds((const unsigned*)((const char*)(gbase) + (voff)[_i]), (LAS unsigned*)(lds + (bufoff) + ldsw + _i * 8192), 16, 0, 0); } while (0)
#define PG8_LDA(dst, b, h) do { _Pragma("unroll") for (int m = 0; m < 4; ++m) _Pragma("unroll") for (int k = 0; k < 2; ++k) dst[m][k] = *(const LAS bf16x8*)(lds + PG8_SA(b, h) + aoff + m * 2048 + k * 1024); } while (0)
#define PG8_LDB(dst, b, h) do { _Pragma("unroll") for (int n = 0; n < 2; ++n) _Pragma("unroll") for (int k = 0; k < 2; ++k) dst[n][k] = *(const LAS bf16x8*)(lds + PG8_SB(b, h) + boff + n * 2048 + k * 1024); } while (0)
#define PG8_MMA(ai, bj, At, Bt) do { __builtin_amdgcn_s_setprio(1); _Pragma("unroll") for (int m = 0; m < 4; ++m) _Pragma("unroll") for (int n = 0; n < 2; ++n) _Pragma("unroll") for (int k = 0; k < 2; ++k) \
        acc[ai][bj][m][n] = __builtin_amdgcn_mfma_f32_16x16x32_bf16(Bt[n][k], At[m][k], acc[ai][bj][m][n], 0, 0, 0); __builtin_amdgcn_s_setprio(0); } while (0)
#define PG8_WAIT_V(n) asm volatile("s_waitcnt vmcnt(" #n ")" ::: "memory")
#define PG8_WAIT_L(n) asm volatile("s_waitcnt lgkmcnt(" #n ")" ::: "memory")
#define PG8_BAR __builtin_amdgcn_s_barrier()
#define PG8_SCHED __builtin_amdgcn_sched_barrier(0)
    Unit cur, nxt; int ui = 0;
    if (!S.next(0, cur)) return;
    f32x4 acc[2][2][4][2];
#pragma unroll
    for (int a = 0; a < 2; ++a)
#pragma unroll
        for (int b = 0; b < 2; ++b)
#pragma unroll
            for (int m = 0; m < 4; ++m)
#pragma unroll
                for (int n = 0; n < 2; ++n) acc[a][b][m][n] = (f32x4){0.f, 0.f, 0.f, 0.f};
    bf16x8 At[4][2], B0[2][2], B1[2][2];
    const char* cA = (const char*)g.A + (size_t)cur.pm * tstepA; const char* cB = (const char*)g.Bt + (size_t)cur.pn * tstepB;
    f32x4 pf[2];
    E.pre(cur.pm, tid, pf); E.post(0, tid, pf);
    PG8_STAGE(PG8_SB(0, 0), cB, voffB); PG8_STAGE(PG8_SB(0, 1), cB + hstepB, voffB); PG8_STAGE(PG8_SA(0, 0), cA, voffA); PG8_STAGE(PG8_SA(0, 1), cA + hstepA, voffA);
    if (wr == 1) PG8_BAR;
    PG8_WAIT_V(2); PG8_BAR;
    PG8_STAGE(PG8_SB(1, 0), cB + kstep, voffB); PG8_STAGE(PG8_SA(1, 0), cA + kstep, voffA); PG8_STAGE(PG8_SB(1, 1), cB + hstepB + kstep, voffB);
    PG8_WAIT_V(6); PG8_BAR;
    for (;;) {
        const bool has_next = S.next(ui + 1, nxt);
        const char* nA = has_next ? (const char*)g.A + (size_t)nxt.pm * tstepA : cA; const char* nB = has_next ? (const char*)g.Bt + (size_t)nxt.pn * tstepB : cB;
        for (int t = 0; t < nt; t += 2) {
            const bool last = (t == nt - 2);
            const char* a1 = cA + (size_t)(t + 1) * kstep + ((t + 1) >= 8 ? xtra : 0);
            const char* a2 = last ? nA : cA + (size_t)(t + 2) * kstep + ((t + 2) >= 8 ? xtra : 0); const char* b2 = last ? nB : cB + (size_t)(t + 2) * kstep;
            const char* a3 = a2 + kstep; const char* b3 = b2 + kstep;
            PG8_LDB(B0, 0, 0); PG8_LDB(B1, 0, 1); PG8_SCHED; PG8_LDA(At, 0, 0); PG8_STAGE(PG8_SA(1, 1), a1 + hstepA, voffA);
            PG8_WAIT_V(8); PG8_WAIT_L(0); PG8_BAR; PG8_MMA(0, 0, At, B0); PG8_MMA(0, 1, At, B1); PG8_BAR; PG8_SCHED;
            PG8_LDA(At, 0, 1); PG8_STAGE(PG8_SB(0, 0), b2, voffB); PG8_STAGE(PG8_SB(0, 1), b2 + hstepB, voffB); PG8_STAGE(PG8_SA(0, 0), a2, voffA);
            PG8_WAIT_V(8); PG8_WAIT_L(0); PG8_BAR; PG8_MMA(1, 0, At, B0); PG8_MMA(1, 1, At, B1); PG8_BAR; PG8_SCHED;
            PG8_LDB(B0, 1, 0); PG8_LDB(B1, 1, 1); PG8_SCHED; PG8_LDA(At, 1, 0); PG8_STAGE(PG8_SA(0, 1), a2 + hstepA, voffA);
            PG8_WAIT_V(8); PG8_WAIT_L(0); PG8_BAR; PG8_MMA(0, 0, At, B0); PG8_MMA(0, 1, At, B1); PG8_BAR; PG8_SCHED;
            PG8_LDA(At, 1, 1); PG8_STAGE(PG8_SB(1, 0), b3, voffB); PG8_STAGE(PG8_SB(1, 1), b3 + hstepB, voffB); PG8_STAGE(PG8_SA(1, 0), a3, voffA);
            PG8_WAIT_V(8); PG8_WAIT_L(0); PG8_BAR; PG8_MMA(1, 0, At, B0); PG8_MMA(1, 1, At, B1); PG8_BAR; PG8_SCHED;
        }
        if (wr == 0) PG8_BAR;
        if (has_next) E.pre(nxt.pm, tid, pf);
        E(acc, cur, wr, wc, fr, fq, ui & 1);
        if (has_next) E.post((ui + 1) & 1, tid, pf);
        if (!has_next) break;
#pragma unroll
        for (int a = 0; a < 2; ++a)
#pragma unroll
            for (int b = 0; b < 2; ++b)
#pragma unroll
                for (int m = 0; m < 4; ++m)
#pragma unroll
                    for (int n = 0; n < 2; ++n) acc[a][b][m][n] = (f32x4){0.f, 0.f, 0.f, 0.f};
        cur = nxt; cA = nA; cB = nB; ++ui;
        if (wr == 1) PG8_BAR;
    }
    PG8_WAIT_V(0);
    PG8_BAR;
#undef PG8_SA
#undef PG8_SB
#undef PG8_STAGE
#undef PG8_LDA
#undef PG8_LDB
#undef PG8_MMA
#undef PG8_WAIT_V
#undef PG8_WAIT_L
#undef PG8_BAR
#undef PG8_SCHED
}

struct EpiEvenIn {
    bf16_t* P; const float* ss; LAS float* rst;
    __device__ __forceinline__ void pre(int pm, int tid, f32x4 (&r)[2]) const {
        const float* p = ss + ((size_t)pm * BM + (tid >> 1)) * 16 + 8 * (tid & 1);
        r[0] = *(const f32x4*)p; r[1] = *(const f32x4*)(p + 4);
    }
    __device__ __forceinline__ void post(int slot, int tid, const f32x4 (&r)[2]) const {
        const f32x4 t = r[0] + r[1]; float s = (t[0] + t[1]) + (t[2] + t[3]);
        s += __shfl_xor(s, 1);
        if ((tid & 1) == 0) rst[slot * 256 + (tid >> 1)] = __builtin_amdgcn_rsqf(s * (1.0f / 1024.0f) + EPS);
    }
    __device__ __forceinline__ void operator()(const f32x4 (&acc)[2][2][4][2], const Unit& u, int wr, int wc, int fr_, int fq_, int slot) const {
        int fr = fr_, fq = fq_; asm volatile("" : "+v"(fr), "+v"(fq));
        const int pn = u.pn;
        const int col0 = pn * BM + wc * 32 + 8 * fq;
        float rs[2][4];
#pragma unroll
        for (int ai = 0; ai < 2; ++ai)
#pragma unroll
            for (int m = 0; m < 4; ++m) rs[ai][m] = rst[slot * 256 + ai * HALF + wr * 64 + m * 16 + fr];
#pragma unroll
        for (int ai = 0; ai < 2; ++ai)
#pragma unroll
            for (int m = 0; m < 4; ++m) {
                bf16_t* rowp = P + (size_t)(u.pm * BM + ai * HALF + wr * 64 + m * 16 + fr) * EVEN_IN + col0;
#pragma unroll
                for (int bj = 0; bj < 2; ++bj) {
                    f32x4 v0 = acc[ai][bj][m][0] * rs[ai][m], v1 = acc[ai][bj][m][1] * rs[ai][m];
                    *(u32x4*)(rowp + bj * HALF) = pack8(v0, v1);
                }
                asm volatile("" ::: "memory");
            }
    }
};

struct EpiOddIn {
    bf16_t* P; const float* ss; float* ssv; LAS float* rst;
    __device__ __forceinline__ void pre(int pm, int tid, f32x4 (&r)[2]) const {
        const float* p = ss + ((size_t)pm * BM + (tid >> 1)) * 16 + 8 * (tid & 1);
        r[0] = *(const f32x4*)p; r[1] = *(const f32x4*)(p + 4);
    }
    __device__ __forceinline__ void post(int slot, int tid, const f32x4 (&r)[2]) const {
        const f32x4 t = r[0] + r[1]; float s = (t[0] + t[1]) + (t[2] + t[3]);
        s += __shfl_xor(s, 1);
        if ((tid & 1) == 0) rst[slot * 256 + (tid >> 1)] = __builtin_amdgcn_rsqf(s * (1.0f / 1024.0f) + EPS);
    }
    __device__ __forceinline__ void operator()(const f32x4 (&acc)[2][2][4][2], const Unit& u, int wr, int wc, int fr_, int fq_, int slot) const {
        int fr = fr_, fq = fq_; asm volatile("" : "+v"(fr), "+v"(fq));
        const int pn = u.pn, col0 = pn * BM + wc * 32 + 8 * fq;
        float rs[2][4];
#pragma unroll
        for (int ai = 0; ai < 2; ++ai)
#pragma unroll
            for (int m = 0; m < 4; ++m) rs[ai][m] = rst[slot * 256 + ai * HALF + wr * 64 + m * 16 + fr];
#pragma unroll
        for (int ai = 0; ai < 2; ++ai)
#pragma unroll
            for (int m = 0; m < 4; ++m) {
                const int row = u.pm * BM + ai * HALF + wr * 64 + m * 16 + fr;
                const float r = rs[ai][m];
                bf16_t* rowp = P + (size_t)row * ODD_IN + col0;
                float sq = 0.f;
#pragma unroll
                for (int bj = 0; bj < 2; ++bj) {
                    f32x4 v0 = acc[ai][bj][m][0] * r, v1 = acc[ai][bj][m][1] * r;
                    if (pn >= 4 && pn < 8) { v0 = gelu4(v0); v1 = gelu4(v1); sq += sq4(v0) + sq4(v1); }
                    *(u32x4*)(rowp + bj * HALF) = pack8(v0, v1);
                }
                if (pn >= 4 && pn < 8) { sq = fq_sum(sq); if (fq == 0) ssv[(size_t)row * 16 + (pn - 4) * 4 + wc] = sq; }
                asm volatile("" ::: "memory");
            }
    }
};

struct EpiOut {
    float* X; const float* R0; const float* R1; bf16_t* XB; float* ss; bool dry; bool lastl;
    __device__ __forceinline__ void pre(int, int, f32x4 (&)[2]) const {}
    __device__ __forceinline__ void post(int, int, const f32x4 (&)[2]) const {}
    __device__ __forceinline__ void load2(f32x4 (&xv)[2][2][2], const float* rb, int b) const {
#pragma unroll
        for (int mm = 0; mm < 2; ++mm) {
            const float* xp = rb + (size_t)((b >> 1) * HALF + (2 * (b & 1) + mm) * 16) * DM;
#pragma unroll
            for (int bj = 0; bj < 2; ++bj) { xv[mm][bj][0] = *(const f32x4*)(xp + bj * HALF); xv[mm][bj][1] = *(const f32x4*)(xp + bj * HALF + 4); }
        }
    }
    __device__ __forceinline__ void operator()(const f32x4 (&acc)[2][2][4][2], const Unit& u, int wr, int wc, int fr_, int fq_, int slot) const {
        int fr = fr_, fq = fq_; asm volatile("" : "+v"(fr), "+v"(fq));
        const int pn = u.pn, col0 = pn * BM + wc * 32 + 8 * fq;
        const float* rb = ((u.pm * BM < MPROMPT) ? R0 : R1) + (size_t)(u.pm * BM + wr * 64 + fr) * DM + col0;
        f32x4 xa[2][2][2], xb2[2][2][2];
        load2(xa, rb, 0);
#pragma unroll
        for (int b = 0; b < 4; ++b) {
            if (b + 1 < 4) { if (b & 1) load2(xa, rb, b + 1); else load2(xb2, rb, b + 1); }
            const int ai = b >> 1;
#pragma unroll
            for (int mm = 0; mm < 2; ++mm) {
                const int m = 2 * (b & 1) + mm;
                const int row = u.pm * BM + ai * HALF + wr * 64 + m * 16 + fr;
                float* xp = X + (size_t)row * DM + col0; bf16_t* bp = XB + (size_t)row * DM + col0;
                float sq = 0.f;
#pragma unroll
                for (int bj = 0; bj < 2; ++bj) {
                    const f32x4 x0 = ((b & 1) ? xb2[mm][bj][0] : xa[mm][bj][0]) + acc[ai][bj][m][0], x1 = ((b & 1) ? xb2[mm][bj][1] : xa[mm][bj][1]) + acc[ai][bj][m][1];
                    if (!dry) { *(f32x4*)(xp + bj * HALF) = x0; *(f32x4*)(xp + bj * HALF + 4) = x1;
                    if (!lastl) *(u32x4*)(bp + bj * HALF) = pack8(x0, x1); }
                    sq += sq4(x0) + sq4(x1);
                }
                if (!lastl) { sq = fq_sum(sq); if (fq == 0 && !dry) ss[(size_t)row * 16 + pn * 4 + wc] = sq; }
            }
        }
    }
};
}

__device__ __forceinline__ void p0_transpose_item(const float* W, int K, int N, bf16_t* WT, const float* gk, LAS float* scr, int item, int lane) {
    const int nblk = N / 32, kb = item / nblk, nb = item % nblk, k0 = 64 * kb, n0 = 32 * nb;
#pragma unroll
    for (int i = 0; i < 8; ++i) {
        const int kk = 8 * i + (lane >> 3); f32x4 v = *(const f32x4*)(W + (size_t)(k0 + kk) * N + n0 + 4 * (lane & 7));
        if (gk) v = v * gk[k0 + kk];
        LAS float* d = scr + kk * 33 + 4 * (lane & 7); d[0] = v[0]; d[1] = v[1]; d[2] = v[2]; d[3] = v[3];
    }
    LDS_WAIT(); asm volatile("" ::: "memory");
    const int c = lane & 7;
#pragma unroll
    for (int j = 0; j < 4; ++j) { const int n = (lane >> 3) + 8 * j; const LAS float* s = scr + (8 * c) * 33 + n;
        u32x4 o; o.x = cvt_pk_bf16(s[0 * 33], s[1 * 33]); o.y = cvt_pk_bf16(s[2 * 33], s[3 * 33]); o.z = cvt_pk_bf16(s[4 * 33], s[5 * 33]); o.w = cvt_pk_bf16(s[6 * 33], s[7 * 33]);
        *(u32x4*)(WT + (size_t)(n0 + n) * K + k0 + 8 * c) = o; }
    LDS_WAIT(); asm volatile("" ::: "memory");
}

struct Args { const float* in[15]; float* out; unsigned char* ws; int ph_lo, ph_hi; };

__device__ __forceinline__ void prologue(const Args& a, LAS unsigned char* lds, int tid, int lane, int wid) {
    unsigned char* ws = a.ws;
    const int G = gridDim.x, gw = blockIdx.x * 8 + wid, NGW = G * 8;
    LAS float* scr = (LAS float*)(lds + wid * 16384);
    constexpr int I_INE = 16 * 72, I_OUT = 16 * 32, I_INO = 16 * 96, I_POOL = 2 * 4;
    constexpr int NITEMS = 2 * (I_INE + I_OUT + I_INO + I_OUT) + 8 * I_POOL;
    for (int it = gw; it < NITEMS; it += NGW) {
        int r = it;
        if (r < 2 * I_INE) { const int j = r / I_INE; p0_transpose_item(a.in[3] + (size_t)j * 1024 * 2304, 1024, 2304, (bf16_t*)(ws + WS_WINE) + (size_t)j * 2304 * 1024, a.in[2] + j * 1024, scr, r % I_INE, lane); continue; } r -= 2 * I_INE;
        if (r < 2 * I_OUT) { const int j = r / I_OUT; p0_transpose_item(a.in[8] + (size_t)j * 1024 * 1024, 1024, 1024, (bf16_t*)(ws + WS_WOUTE) + (size_t)j * 1024 * 1024, nullptr, scr, r % I_OUT, lane); continue; } r -= 2 * I_OUT;
        if (r < 2 * I_INO) { const int j = r / I_INO; p0_transpose_item(a.in[10] + (size_t)j * 1024 * 3072, 1024, 3072, (bf16_t*)(ws + WS_WINO) + (size_t)j * 3072 * 1024, a.in[9] + j * 1024, scr, r % I_INO, lane); continue; } r -= 2 * I_INO;
        if (r < 2 * I_OUT) { const int j = r / I_OUT; p0_transpose_item(a.in[14] + (size_t)j * 1024 * 1024, 1024, 1024, (bf16_t*)(ws + WS_WOUTO) + (size_t)j * 1024 * 1024, nullptr, scr, r % I_OUT, lane); continue; } r -= 2 * I_OUT;
        { const int mt = r / I_POOL; p0_transpose_item(a.in[4] + (size_t)mt * 128 * 128, 128, 128, (bf16_t*)(ws + WS_POOLW) + (size_t)mt * 128 * 128, nullptr, scr, r % I_POOL, lane); }
    }
    { const float* wsf = a.in[12]; bf16_t* dst = (bf16_t*)(ws + WS_WSB);
      for (int i = (blockIdx.x * 512 + tid) * 4; i < 2 * 8 * 128 * 128; i += G * 512 * 4) { const f32x4 v = *(const f32x4*)(wsf + i); u32x2 o; o.x = cvt_pk_bf16(v[0], v[1]); o.y = cvt_pk_bf16(v[2], v[3]); *(u32x2*)(dst + i) = o; } }
    { float* rope = (float*)(ws + WS_ROPE);
      for (int i = blockIdx.x * 512 + tid; i < 1024; i += G * 512) { const int idx = i >> 4, f = i & 15; const float inv = 1.0f / powf(10000.0f, (float)f / 16.0f); const float ang = (float)idx * inv; rope[i] = cosf(ang); rope[1024 + i] = sinf(ang); } }
    { const float* xp = a.in[0]; const float* xs = a.in[1]; float* ss = (float*)(ws + WS_SS); bf16_t* xb = (bf16_t*)(ws + WS_XB);
      for (int m = gw; m < MTOK; m += NGW) {
          const float* src = (m < MPROMPT) ? xp + (size_t)m * DM : xs + (size_t)(m - MPROMPT) * DM;
          f32x4 v[4]; float s = 0.f;
#pragma unroll
          for (int j = 0; j < 4; ++j) { v[j] = *(const f32x4*)(src + (lane + 64 * j) * 4); s += sq4(v[j]); }
          s = wave_sum(s);
#pragma unroll
          for (int j = 0; j < 4; ++j) { u32x2 o; o.x = cvt_pk_bf16(v[j][0], v[j][1]); o.y = cvt_pk_bf16(v[j][2], v[j][3]); *(u32x2*)(xb + (size_t)m * DM + (lane + 64 * j) * 4) = o; }
          if (lane < 16) ss[(size_t)m * 16 + lane] = (lane == 0) ? s : 0.f;
      } }
}

__device__ __forceinline__ void kprep_item(bf16_t* P, const float* kg, const float* rope, int idx, const u32x4 w) {
    const int e8 = idx & 7, hk = (idx >> 3) & 1, row = idx >> 4;
    float x[8] = {bflo(w.x), bfhi(w.x), bflo(w.y), bfhi(w.y), bflo(w.z), bfhi(w.z), bflo(w.w), bfhi(w.w)};
    float ssq = 0.f;
#pragma unroll
    for (int e = 0; e < 8; ++e) ssq += x[e] * x[e];
    ssq += __shfl_xor(ssq, 1); ssq += __shfl_xor(ssq, 2); ssq += __shfl_xor(ssq, 4);
    const float rh = __builtin_amdgcn_rsqf(ssq * (1.0f / 64.0f) + EPS);
    const int t = row & (SEQ - 1), ir = (e8 < 4) ? (t >> 6) : (t & 63), f0 = 8 * (e8 & 1);
    const f32x4 g0 = *(const f32x4*)(kg + e8 * 8), g1 = *(const f32x4*)(kg + e8 * 8 + 4);
    const f32x4 c0 = *(const f32x4*)(rope + ir * 16 + f0), c1 = *(const f32x4*)(rope + ir * 16 + f0 + 4);
    const f32x4 s0 = *(const f32x4*)(rope + 1024 + ir * 16 + f0), s1 = *(const f32x4*)(rope + 1024 + ir * 16 + f0 + 4);
    const float sgn = (e8 & 2) ? 1.0f : -1.0f;
    float o[8];
#pragma unroll
    for (int e = 0; e < 8; ++e) {
        const float y = x[e] * rh * (e < 4 ? g0[e & 3] : g1[e & 3]);
        const float other = __shfl_xor(y, 2);
        o[e] = y * (e < 4 ? c0[e & 3] : c1[e & 3]) + sgn * other * (e < 4 ? s0[e & 3] : s1[e & 3]);
    }
    u32x4 r; r.x = cvt_pk_bf16(o[0], o[1]); r.y = cvt_pk_bf16(o[2], o[3]); r.z = cvt_pk_bf16(o[4], o[5]); r.w = cvt_pk_bf16(o[6], o[7]);
    *(u32x4*)(P + (size_t)row * EVEN_IN + 1536 + hk * 64 + e8 * 8) = r;
}
__device__ __forceinline__ void kprep_phase(bf16_t* P, const float* kg, const float* rope, int tid, int bx, int G) {
    const int stride = G * 512;
    for (int base = bx * 512 + tid; base < MTOK * 16; base += 3 * stride) {
        u32x4 w[3];
#pragma unroll
        for (int q = 0; q < 3; ++q) { const int idx = base + q * stride; if (idx < MTOK * 16) w[q] = *(const u32x4*)(P + (size_t)(idx >> 4) * EVEN_IN + 1536 + ((idx >> 3) & 1) * 64 + (idx & 7) * 8); }
#pragma unroll
        for (int q = 0; q < 3; ++q) { const int idx = base + q * stride; if (idx < MTOK * 16) kprep_item(P, kg, rope, idx, w[q]); }
    }
}

#define MFMA32(a, b, c) __builtin_amdgcn_mfma_f32_32x32x16_bf16(a, b, c, 0, 0, 0)
#define MFMA16(a, b, c) __builtin_amdgcn_mfma_f32_16x16x32_bf16(a, b, c, 0, 0, 0)
__device__ __forceinline__ s16x4 vtr(const LAS unsigned char* p) { return __builtin_bit_cast(s16x4, __builtin_amdgcn_ds_read_tr16_b64_v4i16((LAS s16x4*)p)); }
__device__ __forceinline__ float max3f(float a, float b, float c) { return __builtin_fmaxf(__builtin_fmaxf(a, b), c); }

#define ABAR() asm volatile("s_waitcnt lgkmcnt(0)\n\ts_barrier" ::: "memory")
#define SGB(mask, n) __builtin_amdgcn_sched_group_barrier(mask, n, 0)
typedef __bf16 bf16v2 __attribute__((ext_vector_type(2)));
__device__ __forceinline__ unsigned cvtpk(float a, float b) { const bf16v2 r = __builtin_convertvector((f32x2){a, b}, bf16v2); return __builtin_bit_cast(unsigned, r); }
__device__ __forceinline__ float pairmax(float m) { auto rr = __builtin_amdgcn_permlane32_swap(__float_as_uint(m), __float_as_uint(m), false, false); return __builtin_fmaxf(__uint_as_float(rr[0]), __uint_as_float(rr[1])); }
__device__ __forceinline__ float rowmax32(const f32x16& p0, const f32x16& p1) {
    float a = max3f(p0[0], p0[1], p1[0]), b = max3f(p0[2], p0[3], p1[1]); a = max3f(a, p1[2], p1[3]);
#pragma unroll
    for (int r = 4; r < 16; r += 4) { a = max3f(a, p0[r], p0[r + 1]); b = max3f(b, p0[r + 2], p0[r + 3]); a = max3f(a, p1[r], p1[r + 1]); b = max3f(b, p1[r + 2], p1[r + 3]); }
    return pairmax(__builtin_fmaxf(a, b));
}
#define SBAR() __builtin_amdgcn_sched_barrier(0)
#define PIN(x) asm volatile("" : "+v"(x))
#define VCHUNK(PC, KB, R) do { \
        float e0_ = __builtin_amdgcn_exp2f(PC[(R)]), e1_ = __builtin_amdgcn_exp2f(PC[(R) + 1]), e2_ = __builtin_amdgcn_exp2f(PC[(R) + 2]), e3_ = __builtin_amdgcn_exp2f(PC[(R) + 3]); \
        s0 += e0_; s1 += e1_; s2 += e2_; s3 += e3_; pw[KB][(R) / 2] = cvtpk(e0_, e1_); pw[KB][(R) / 2 + 1] = cvtpk(e2_, e3_); \
        PIN(pw[KB][(R) / 2]); PIN(pw[KB][(R) / 2 + 1]); PIN(s0); PIN(s1); PIN(s2); PIN(s3); } while (0)
#define VTR4(J) do { const LAS unsigned char* vb_ = vc + (J) * 1024; va0 = vtr(vb_); va1 = vtr(vb_ + 512); vb0 = vtr(vb_ + 4096); vb1 = vtr(vb_ + 4096 + 512); } while (0)
#define PVJ(J) do { const u32x4 pbw_ = {pw[(J) >> 1][4 * ((J) & 1)], pw[(J) >> 1][4 * ((J) & 1) + 1], pw[(J) >> 1][4 * ((J) & 1) + 2], pw[(J) >> 1][4 * ((J) & 1) + 3]}; \
        const bf16x8 pb_ = __builtin_bit_cast(bf16x8, pbw_); \
        const bf16x8 fa_ = {va0[0], va0[1], va0[2], va0[3], va1[0], va1[1], va1[2], va1[3]}; const bf16x8 fb_ = {vb0[0], vb0[1], vb0[2], vb0[3], vb1[0], vb1[1], vb1[2], vb1[3]}; \
        o0 = MFMA32(fa_, pb_, o0); o1 = MFMA32(fb_, pb_, o1); } while (0)
#define ASTEP(T, PC0, PC1, PN0, PN1, KRO, VRO, KRN, VRN) do { \
        const int t_ = (T); \
        if (t_ + 3 < NT) KRN = *(const u32x4*)(ksrc + (size_t)(t_ + 3) * 64 * EVEN_IN); \
        if (t_ + 2 < NT) VRN = *(const u32x4*)(vsrc + (size_t)(t_ + 2) * 64 * EVEN_IN); \
        const LAS unsigned char* kn = lds + ((t_ + 1) & 1) * 8192 + koff; \
        const LAS unsigned char* vc = lds + (t_ & 1) * 8192 + voff; \
        bf16x8 kf[8]; \
        _Pragma("unroll") for (int d0 = 0; d0 < 4; ++d0) { kf[2 * d0] = *(const LAS bf16x8*)(kn + d0 * 2048); kf[2 * d0 + 1] = *(const LAS bf16x8*)(kn + d0 * 2048 + 512); } \
        unsigned pw[2][8]; float s0 = 0.f, s1 = 0.f, s2 = 0.f, s3 = 0.f; s16x4 va0, va1, vb0, vb1; \
        SBAR(); \
        VCHUNK(PC0, 0, 0); VCHUNK(PC1, 1, 0); SBAR(); \
        PN0 = MFMA32(kf[0], qf[0], negm); VCHUNK(PC0, 0, 4); SBAR(); \
        PN1 = MFMA32(kf[1], qf[0], negm); VCHUNK(PC1, 1, 4); SBAR(); \
        PN0 = MFMA32(kf[2], qf[1], PN0); VCHUNK(PC0, 0, 8); SBAR(); \
        PN1 = MFMA32(kf[3], qf[1], PN1); VCHUNK(PC1, 1, 8); SBAR(); \
        PN0 = MFMA32(kf[4], qf[2], PN0); VCHUNK(PC0, 0, 12); SBAR(); \
        PN1 = MFMA32(kf[5], qf[2], PN1); VCHUNK(PC1, 1, 12); SBAR(); \
        PN0 = MFMA32(kf[6], qf[3], PN0); VTR4(0); lsum += (s0 + s1) + (s2 + s3); SBAR(); \
        PN1 = MFMA32(kf[7], qf[3], PN1); SBAR(); \
        PVJ(0); VTR4(1); \
        float ma_ = max3f(PN0[0], PN0[1], PN0[2]); ma_ = max3f(ma_, PN0[3], PN0[4]); ma_ = max3f(ma_, PN0[5], PN0[6]); ma_ = max3f(ma_, PN0[7], PN0[8]); PIN(ma_); SBAR(); \
        PVJ(1); VTR4(2); \
        ma_ = max3f(ma_, PN0[9], PN0[10]); ma_ = max3f(ma_, PN0[11], PN0[12]); ma_ = max3f(ma_, PN0[13], PN0[14]); ma_ = max3f(ma_, PN0[15], PN1[0]); PIN(ma_); SBAR(); \
        PVJ(2); VTR4(3); \
        float mb_ = max3f(PN1[1], PN1[2], PN1[3]); mb_ = max3f(mb_, PN1[4], PN1[5]); mb_ = max3f(mb_, PN1[6], PN1[7]); mb_ = max3f(mb_, PN1[8], PN1[9]); PIN(mb_); SBAR(); \
        PVJ(3); \
        mb_ = max3f(mb_, PN1[10], PN1[11]); mb_ = max3f(mb_, PN1[12], PN1[13]); mb_ = max3f(mb_, PN1[14], PN1[15]); \
        const float mt_ = pairmax(__builtin_fmaxf(ma_, mb_)); \
        SBAR(); \
        if (t_ + 2 < NT) *(LAS u32x4*)(lds + (t_ & 1) * 8192 + kdst) = KRO; \
        if (t_ + 1 < NT) *(LAS u32x4*)(lds + ((t_ + 1) & 1) * 8192 + vdst) = VRO; \
        if (__builtin_amdgcn_ballot_w64(mt_ > THR) != 0ull) { \
            const float d_ = __builtin_fmaxf(mt_, 0.f), alpha_ = __builtin_amdgcn_exp2f(-d_); \
            mref += d_; lsum *= alpha_; \
            _Pragma("unroll") for (int r = 0; r < 16; ++r) { o0[r] *= alpha_; o1[r] *= alpha_; PN0[r] -= d_; PN1[r] -= d_; negm[r] = -mref; } \
        } \
        ABAR(); } while (0)
__device__ __forceinline__ void attn_unit(LAS unsigned char* lds, bf16_t* P, const float* qgain, const float* rope, int s, int h, int qb, int lane, int wid, bool dry) {
    const int r32 = lane & 31, hi = lane >> 5, kvh = h >> 2;
    const size_t rowbase = (size_t)s * SEQ;
    const bf16_t* ksrc = P + (rowbase + lane) * EVEN_IN + 1536 + kvh * 64 + wid * 8;
    const bf16_t* vsrc = P + (rowbase + 16 * (wid & 3) + (lane >> 2)) * EVEN_IN + 1664 + kvh * 64 + (wid >> 2) * 32 + (lane & 3) * 8;
    const int kdst = wid * 1024 + lane * 16;
    const int vdst = 16384 + (wid >> 2) * 4096 + (16 * (wid & 3) + (lane >> 2)) * 64 + (lane & 3) * 16;
    const size_t qrow = rowbase + (size_t)qb * 256 + wid * 32 + r32;
    const bf16_t* qg = P + qrow * EVEN_IN + 1024 + h * 64 + hi * 8;
    u32x4 krA = *(const u32x4*)ksrc, vrA = *(const u32x4*)vsrc;
    u32x4 krB = *(const u32x4*)(ksrc + (size_t)64 * EVEN_IN), vrB;
    bf16x8 qf[4];
    {
        float y[4][8]; float ssq = 0.f;
#pragma unroll
        for (int d0 = 0; d0 < 4; ++d0) { const u32x4 w = *(const u32x4*)(qg + d0 * 16);
            y[d0][0] = bflo(w.x); y[d0][1] = bfhi(w.x); y[d0][2] = bflo(w.y); y[d0][3] = bfhi(w.y); y[d0][4] = bflo(w.z); y[d0][5] = bfhi(w.z); y[d0][6] = bflo(w.w); y[d0][7] = bfhi(w.w);
#pragma unroll
            for (int e = 0; e < 8; ++e) ssq += y[d0][e] * y[d0][e]; }
        { const auto rr = __builtin_amdgcn_permlane32_swap(__float_as_uint(ssq), __float_as_uint(ssq), false, false); ssq = __uint_as_float(rr[0]) + __uint_as_float(rr[1]); }
        const float rh = __builtin_amdgcn_rsqf(ssq * (1.0f / 64.0f) + EPS) * C2;
        const int tq = qb * 256 + wid * 32 + r32;
#pragma unroll
        for (int d0 = 0; d0 < 4; ++d0) { const f32x4 g0 = *(const f32x4*)(qgain + d0 * 16 + hi * 8), g1 = *(const f32x4*)(qgain + d0 * 16 + hi * 8 + 4);
#pragma unroll
            for (int e = 0; e < 8; ++e) y[d0][e] *= rh * (e < 4 ? g0[e & 3] : g1[e & 3]); }
#pragma unroll
        for (int hf = 0; hf < 2; ++hf) {
            const int ir = hf ? (tq & 63) : (tq >> 6);
            const f32x4 c0 = *(const f32x4*)(rope + ir * 16 + 8 * hi), c1 = *(const f32x4*)(rope + ir * 16 + 8 * hi + 4);
            const f32x4 s0 = *(const f32x4*)(rope + 1024 + ir * 16 + 8 * hi), s1 = *(const f32x4*)(rope + 1024 + ir * 16 + 8 * hi + 4);
            u32x4 wa, wb; unsigned* pa = (unsigned*)&wa; unsigned* pb = (unsigned*)&wb; (void)pa; (void)pb;
            float oa[8], ob[8];
#pragma unroll
            for (int e = 0; e < 8; ++e) { const float c = (e < 4 ? c0[e & 3] : c1[e & 3]), sn = (e < 4 ? s0[e & 3] : s1[e & 3]); const float x1 = y[2 * hf][e], x2 = y[2 * hf + 1][e];
                oa[e] = x1 * c - x2 * sn; ob[e] = x2 * c + x1 * sn; }
            wa.x = cvt_pk_bf16(oa[0], oa[1]); wa.y = cvt_pk_bf16(oa[2], oa[3]); wa.z = cvt_pk_bf16(oa[4], oa[5]); wa.w = cvt_pk_bf16(oa[6], oa[7]);
            wb.x = cvt_pk_bf16(ob[0], ob[1]); wb.y = cvt_pk_bf16(ob[2], ob[3]); wb.z = cvt_pk_bf16(ob[4], ob[5]); wb.w = cvt_pk_bf16(ob[6], ob[7]);
            qf[2 * hf] = __builtin_bit_cast(bf16x8, wa); qf[2 * hf + 1] = __builtin_bit_cast(bf16x8, wb);
        }
    }
    *(LAS u32x4*)(lds + kdst) = krA; *(LAS u32x4*)(lds + vdst) = vrA; *(LAS u32x4*)(lds + 8192 + kdst) = krB;
    asm volatile("s_waitcnt vmcnt(0) lgkmcnt(0)\n\ts_barrier" ::: "memory");
    krA = *(const u32x4*)(ksrc + (size_t)2 * 64 * EVEN_IN); vrA = *(const u32x4*)(vsrc + (size_t)64 * EVEN_IN);
    const int koff = hi * 1024 + r32 * 16;
    const int voff = 16384 + ((lane >> 4) & 1) * 32 + (lane & 3) * 8 + (4 * hi + ((lane & 15) >> 2)) * 64;
    float mref, lsum = 0.f;
    f32x16 o0 = {}, o1 = {}, pA0 = {}, pA1 = {}, pB0, pB1;
    {
#pragma unroll
        for (int d0 = 0; d0 < 4; ++d0) {
            const bf16x8 k0 = *(const LAS bf16x8*)(lds + koff + d0 * 2048), k1 = *(const LAS bf16x8*)(lds + koff + d0 * 2048 + 512);
            pA0 = MFMA32(k0, qf[d0], pA0); pA1 = MFMA32(k1, qf[d0], pA1);
        }
        mref = rowmax32(pA0, pA1);
#pragma unroll
        for (int r = 0; r < 16; ++r) { pA0[r] -= mref; pA1[r] -= mref; }
    }
    f32x16 negm;
#pragma unroll
    for (int r = 0; r < 16; ++r) negm[r] = -mref;
    constexpr int NT = SEQ / 64;
    constexpr float THR = 8.0f;
    for (int t = 0; t < NT; t += 2) {
        ASTEP(t, pA0, pA1, pB0, pB1, krA, vrA, krB, vrB);
        ASTEP(t + 1, pB0, pB1, pA0, pA1, krB, vrB, krA, vrA);
    }
    lsum += __shfl_xor(lsum, 32);
    const float inv = 1.0f / lsum;
    bf16_t* op = P + qrow * EVEN_IN + 1792 + h * 64 + 4 * hi;
    u32x2 zq[8];
#pragma unroll
    for (int i = 0; i < 4; ++i) { zq[i] = *(const u32x2*)(op + 8 * i); zq[4 + i] = *(const u32x2*)(op + 32 + 8 * i); }
    if (!dry)
#pragma unroll
    for (int i = 0; i < 4; ++i) {
        { const u32x2 z = zq[i]; u32x2 w;
          w.x = cvt_pk_bf16(o0[4 * i] * inv * silu_f(bflo(z.x)), o0[4 * i + 1] * inv * silu_f(bfhi(z.x))); w.y = cvt_pk_bf16(o0[4 * i + 2] * inv * silu_f(bflo(z.y)), o0[4 * i + 3] * inv * silu_f(bfhi(z.y))); *(u32x2*)(op + 8 * i) = w; }
        { const u32x2 z = zq[4 + i]; u32x2 w;
          w.x = cvt_pk_bf16(o1[4 * i] * inv * silu_f(bflo(z.x)), o1[4 * i + 1] * inv * silu_f(bfhi(z.x))); w.y = cvt_pk_bf16(o1[4 * i + 2] * inv * silu_f(bflo(z.y)), o1[4 * i + 3] * inv * silu_f(bfhi(z.y))); *(u32x2*)(op + 32 + 8 * i) = w; }
    }
}

__device__ __forceinline__ void pool_loadU(u32x4 (&ur)[10], const bf16_t* P, int it, int tid) {
    const int t0 = (it & 63) * 64; const size_t rowbase = (size_t)(it >> 6) * SEQ;
#pragma unroll
    for (int i = 0; i < 10; ++i) {
        const int idx = tid + 512 * i, row = idx >> 6, ch = idx & 63, t = t0 - 8 + row;
        u32x4 v = {0u, 0u, 0u, 0u};
        if (t >= 0 && t < SEQ) v = *(const u32x4*)(P + (rowbase + t) * EVEN_IN + ch * 8);
        ur[i] = v;
    }
}
__device__ __forceinline__ void pool_run(LAS unsigned char* lds, bf16_t* P, const bf16_t* pwT, const float* pscale, int it0, int step, int tid, int lane, int wid, bool dry) {
    LAS unsigned char* U = lds; LAS unsigned char* DF = lds + 81920;
    u32x4 ur[10];
    if (it0 < 768) pool_loadU(ur, P, it0, tid);
    for (int it = it0; it < 768; it += step) {
    const int t0 = (it & 63) * 64; const size_t rowbase = (size_t)(it >> 6) * SEQ;
    u32x2 zz[8][2];
    { const int g = wid >> 1, th = wid & 1, fr = lane & 15, fq = lane >> 4;
#pragma unroll
      for (int db = 0; db < 8; ++db)
#pragma unroll
          for (int tb = 0; tb < 2; ++tb)
              zz[db][tb] = *(const u32x2*)(P + (rowbase + t0 + 32 * th + 16 * tb + fr) * EVEN_IN + 512 + g * 128 + 16 * db + 4 * fq); }
#pragma unroll
    for (int i = 0; i < 10; ++i) { const int idx = tid + 512 * i; *(LAS u32x4*)(U + (idx >> 6) * 1024 + (idx & 63) * 16) = ur[i]; }
    __syncthreads();
    if (it + step < 768) pool_loadU(ur, P, it + step, tid);
    bf16x8 af0[8];
    { const int g = wid >> 1, fr = lane & 15, fq = lane >> 4;
#pragma unroll
      for (int db = 0; db < 8; ++db) af0[db] = *(const bf16x8*)(pwT + ((size_t)(g * 128 + 16 * db + fr) * 128 + 8 * fq)); }
    {
        const int cp = tid & 255, half = tid >> 8, g = cp >> 6, w2 = 1 << g, tl0 = half * 32;
        const LAS unsigned* U32 = (const LAS unsigned*)U; LAS unsigned* D32 = (LAS unsigned*)DF;
        float sx = 0.f, sy = 0.f;
        for (int r = tl0 + 8 - w2; r < tl0 + 8 + w2; ++r) { const unsigned w = U32[r * 256 + cp]; sx += bflo(w); sy += bfhi(w); }
#pragma unroll 8
        for (int i = 0; i < 32; ++i) {
            const int tl = tl0 + i, t = t0 + tl;
            const int lo = (t - w2) < 0 ? 0 : (t - w2), hi2 = (t + w2) > SEQ ? SEQ : (t + w2);
            const float inv = 1.0f / (float)(hi2 - lo);
            const unsigned w = U32[(tl + 8) * 256 + cp];
            D32[tl * 260 + cp] = cvt_pk_bf16(sx * inv - bflo(w), sy * inv - bfhi(w));
            const unsigned wa = U32[(tl + 8 + w2) * 256 + cp], wb = U32[(tl + 8 - w2) * 256 + cp];
            sx += bflo(wa) - bflo(wb); sy += bfhi(wa) - bfhi(wb);
        }
    }
    __syncthreads();
    {
        const int g = wid >> 1, th = wid & 1, fr = lane & 15, fq = lane >> 4;
        f32x4 acc[8][2];
#pragma unroll
        for (int db = 0; db < 8; ++db) { acc[db][0] = (f32x4){0.f, 0.f, 0.f, 0.f}; acc[db][1] = (f32x4){0.f, 0.f, 0.f, 0.f}; }
#pragma unroll
        for (int ks = 0; ks < 4; ++ks) {
            const bf16x8 b0 = *(const LAS bf16x8*)(DF + (32 * th + fr) * 1040 + (g * 128 + 32 * ks + 8 * fq) * 2);
            const bf16x8 b1 = *(const LAS bf16x8*)(DF + (32 * th + 16 + fr) * 1040 + (g * 128 + 32 * ks + 8 * fq) * 2);
#pragma unroll
            for (int db = 0; db < 8; ++db) {
                const bf16x8 af = (ks == 0) ? af0[db] : *(const bf16x8*)(pwT + ((size_t)(g * 128 + 16 * db + fr) * 128 + 32 * ks + 8 * fq));
                acc[db][0] = MFMA16(af, b0, acc[db][0]); acc[db][1] = MFMA16(af, b1, acc[db][1]);
            }
        }
#pragma unroll
        for (int db = 0; db < 8; ++db) {
            const int col = g * 128 + 16 * db + 4 * fq;
            const f32x4 sc = *(const f32x4*)(pscale + col);
#pragma unroll
            for (int tb = 0; tb < 2; ++tb) {
                const int t = 32 * th + 16 * tb + fr;
                u32x2* pp = (u32x2*)(P + (rowbase + t0 + t) * EVEN_IN + 512 + col);
                const u32x2 z = zz[db][tb]; const f32x4 a = acc[db][tb] * sc; u32x2 w;
                w.x = cvt_pk_bf16(a[0] * silu_f(bflo(z.x)), a[1] * silu_f(bfhi(z.x))); w.y = cvt_pk_bf16(a[2] * silu_f(bflo(z.y)), a[3] * silu_f(bfhi(z.y))); if (!dry) *pp = w;
            }
        }
    }
    __syncthreads();
    }
}

__device__ __forceinline__ void sgu_item(LAS unsigned char* lds, bf16_t* P, const bf16_t* wsb, const float* bs, const float* sg, const float* ssv, int ch, int h, bool load_w, int tid, int lane, int wid, bool dry) {
    LAS unsigned char* GV = lds; LAS unsigned char* WT = lds + 36864; LAS unsigned char* GU = lds + 71680; LAS unsigned char* SZ = lds + 106496;
    const size_t row0 = (size_t)ch * 128;
#pragma unroll
    for (int i = 0; i < 4; ++i) {
        const int idx = tid + 512 * i, r = idx >> 4, c16 = idx & 15;
        const bf16_t* src = P + (row0 + r) * ODD_IN + h * 128 + c16 * 8;
        const u32x4 gu = *(const u32x4*)src, gv = *(const u32x4*)(src + 1024), sz = *(const u32x4*)(src + 2048);
        float part = ssv[(row0 + r) * 16 + c16];
        part += __shfl_xor(part, 1); part += __shfl_xor(part, 2); part += __shfl_xor(part, 4); part += __shfl_xor(part, 8);
        const float rv = __builtin_amdgcn_rsqf(part * (1.0f / 1024.0f) + EPS);
        const f32x4 g0 = *(const f32x4*)(sg + h * 128 + c16 * 8) * rv, g1 = *(const f32x4*)(sg + h * 128 + c16 * 8 + 4) * rv;
        u32x4 gn;
        gn.x = cvt_pk_bf16(bflo(gv.x) * g0[0], bfhi(gv.x) * g0[1]); gn.y = cvt_pk_bf16(bflo(gv.y) * g0[2], bfhi(gv.y) * g0[3]);
        gn.z = cvt_pk_bf16(bflo(gv.z) * g1[0], bfhi(gv.z) * g1[1]); gn.w = cvt_pk_bf16(bflo(gv.w) * g1[2], bfhi(gv.w) * g1[3]);
        *(LAS u32x4*)(GV + r * 288 + c16 * 16) = gn;
        *(LAS u32x4*)(GU + r * 272 + c16 * 16) = gu;
        *(LAS u32x4*)(SZ + r * 272 + c16 * 16) = sz;
        if (load_w) *(LAS u32x4*)(WT + r * 272 + c16 * 16) = *(const u32x4*)(wsb + ((size_t)(h * 128 + r) * 128 + c16 * 8));
    }
    __syncthreads();
    {
        const int fr = lane & 15, fq = lane >> 4;
        bf16x8 af[4];
#pragma unroll
        for (int ks = 0; ks < 4; ++ks) {
            const LAS unsigned char* ap = GV + (32 * ks + 8 * fq + (fr >> 2)) * 288 + (16 * wid + 4 * (fr & 3)) * 2;
            const s16x4 a0 = vtr(ap), a1 = vtr(ap + 4 * 288);
            af[ks] = (bf16x8){a0[0], a0[1], a0[2], a0[3], a1[0], a1[1], a1[2], a1[3]};
        }
        f32x4 acc[8];
#pragma unroll
        for (int pb = 0; pb < 8; ++pb) acc[pb] = (f32x4){0.f, 0.f, 0.f, 0.f};
#pragma unroll
        for (int ks = 0; ks < 4; ++ks)
#pragma unroll
            for (int pb = 0; pb < 8; ++pb) {
                const bf16x8 bfr = *(const LAS bf16x8*)(WT + (16 * pb + fr) * 272 + (32 * ks + 8 * fq) * 2);
                acc[pb] = MFMA16(af[ks], bfr, acc[pb]);
            }
#pragma unroll
        for (int pb = 0; pb < 8; ++pb) {
            const int p = 16 * pb + fr; const float bias = bs[h * 128 + p];
            LAS u32x2* gp = (LAS u32x2*)(GU + p * 272 + (16 * wid + 4 * fq) * 2);
            const u32x2 gu = *gp, sz = *(const LAS u32x2*)(SZ + p * 272 + (16 * wid + 4 * fq) * 2);
            u32x2 w;
            const f32x4 ug = gelu4((f32x4){bflo(gu.x), bfhi(gu.x), bflo(gu.y), bfhi(gu.y)});
            const f32x4 zs = silu4((f32x4){bflo(sz.x), bfhi(sz.x), bflo(sz.y), bfhi(sz.y)});
            w.x = cvt_pk_bf16(ug[0] * (acc[pb][0] + bias) * zs[0], ug[1] * (acc[pb][1] + bias) * zs[1]);
            w.y = cvt_pk_bf16(ug[2] * (acc[pb][2] + bias) * zs[2], ug[3] * (acc[pb][3] + bias) * zs[3]);
            *gp = w;
        }
    }
    __syncthreads();
#pragma unroll
    for (int i = 0; i < 4; ++i) {
        const int idx = tid + 512 * i, r = idx >> 4, c16 = idx & 15;
        if (!dry) *(u32x4*)(P + (row0 + r) * ODD_IN + h * 128 + c16 * 8) = *(const LAS u32x4*)(GU + r * 272 + c16 * 16);
    }
    __syncthreads();
}


__device__ __forceinline__ void sgu_load(u32x4 (&gu)[4], u32x4 (&gv)[4], u32x4 (&sz)[4], float (&part)[4], const bf16_t* P, const float* ssv, int ch, int h, int tid) {
    const size_t row0 = (size_t)ch * 128;
#pragma unroll
    for (int i = 0; i < 4; ++i) {
        const int idx = tid + 512 * i, r = idx >> 4, c16 = idx & 15;
        const bf16_t* src = P + (row0 + r) * ODD_IN + h * 128 + c16 * 8;
        gu[i] = *(const u32x4*)src; gv[i] = *(const u32x4*)(src + 1024); sz[i] = *(const u32x4*)(src + 2048);
        part[i] = ssv[(row0 + r) * 16 + c16];
    }
}
__device__ __forceinline__ void sgu_run(LAS unsigned char* lds, bf16_t* P, const bf16_t* wsb, const float* bs, const float* sg, const float* ssv, int ch0, int cstep, int h, int tid, int lane, int wid, bool dry) {
    LAS unsigned char* GV = lds; LAS unsigned char* WT = lds + 36864; LAS unsigned char* GU = lds + 71680; LAS unsigned char* SZ = lds + 106496;
    u32x4 gu[4], gv[4], sz[4]; float part[4];
    if (ch0 < 384) sgu_load(gu, gv, sz, part, P, ssv, ch0, h, tid);
    bool first = true;
    for (int ch = ch0; ch < 384; ch += cstep) {
        const size_t row0 = (size_t)ch * 128;
#pragma unroll
        for (int i = 0; i < 4; ++i) {
            const int idx = tid + 512 * i, r = idx >> 4, c16 = idx & 15;
            float pt = part[i];
            pt += __shfl_xor(pt, 1); pt += __shfl_xor(pt, 2); pt += __shfl_xor(pt, 4); pt += __shfl_xor(pt, 8);
            const float rv = __builtin_amdgcn_rsqf(pt * (1.0f / 1024.0f) + EPS);
            const f32x4 g0 = *(const f32x4*)(sg + h * 128 + c16 * 8) * rv, g1 = *(const f32x4*)(sg + h * 128 + c16 * 8 + 4) * rv;
            u32x4 gn;
            gn.x = cvt_pk_bf16(bflo(gv[i].x) * g0[0], bfhi(gv[i].x) * g0[1]); gn.y = cvt_pk_bf16(bflo(gv[i].y) * g0[2], bfhi(gv[i].y) * g0[3]);
            gn.z = cvt_pk_bf16(bflo(gv[i].z) * g1[0], bfhi(gv[i].z) * g1[1]); gn.w = cvt_pk_bf16(bflo(gv[i].w) * g1[2], bfhi(gv[i].w) * g1[3]);
            *(LAS u32x4*)(GV + r * 288 + c16 * 16) = gn;
            *(LAS u32x4*)(GU + r * 272 + c16 * 16) = gu[i];
            *(LAS u32x4*)(SZ + r * 272 + c16 * 16) = sz[i];
            if (first) *(LAS u32x4*)(WT + r * 272 + c16 * 16) = *(const u32x4*)(wsb + ((size_t)(h * 128 + r) * 128 + c16 * 8));
        }
        first = false;
        __syncthreads();
        if (ch + cstep < 384) sgu_load(gu, gv, sz, part, P, ssv, ch + cstep, h, tid);
        {
            const int fr = lane & 15, fq = lane >> 4;
            bf16x8 af[4];
#pragma unroll
            for (int ks = 0; ks < 4; ++ks) {
                const LAS unsigned char* ap = GV + (32 * ks + 8 * fq + (fr >> 2)) * 288 + (16 * wid + 4 * (fr & 3)) * 2;
                const s16x4 a0 = vtr(ap), a1 = vtr(ap + 4 * 288);
                af[ks] = (bf16x8){a0[0], a0[1], a0[2], a0[3], a1[0], a1[1], a1[2], a1[3]};
            }
            f32x4 acc[8];
#pragma unroll
            for (int pb = 0; pb < 8; ++pb) acc[pb] = (f32x4){0.f, 0.f, 0.f, 0.f};
#pragma unroll
            for (int ks = 0; ks < 4; ++ks)
#pragma unroll
                for (int pb = 0; pb < 8; ++pb) {
                    const bf16x8 bfr = *(const LAS bf16x8*)(WT + (16 * pb + fr) * 272 + (32 * ks + 8 * fq) * 2);
                    acc[pb] = MFMA16(af[ks], bfr, acc[pb]);
                }
#pragma unroll
            for (int pb = 0; pb < 8; ++pb) {
                const int p = 16 * pb + fr; const float bias = bs[h * 128 + p];
                LAS u32x2* gp = (LAS u32x2*)(GU + p * 272 + (16 * wid + 4 * fq) * 2);
                const u32x2 gu2 = *gp, sz2 = *(const LAS u32x2*)(SZ + p * 272 + (16 * wid + 4 * fq) * 2);
                u32x2 w;
                const f32x4 ug = gelu4((f32x4){bflo(gu2.x), bfhi(gu2.x), bflo(gu2.y), bfhi(gu2.y)});
                const f32x4 zs = silu4((f32x4){bflo(sz2.x), bfhi(sz2.x), bflo(sz2.y), bfhi(sz2.y)});
                w.x = cvt_pk_bf16(ug[0] * (acc[pb][0] + bias) * zs[0], ug[1] * (acc[pb][1] + bias) * zs[1]);
                w.y = cvt_pk_bf16(ug[2] * (acc[pb][2] + bias) * zs[2], ug[3] * (acc[pb][3] + bias) * zs[3]);
                *gp = w;
            }
        }
        __syncthreads();
#pragma unroll
        for (int i = 0; i < 4; ++i) {
            const int idx = tid + 512 * i, r = idx >> 4, c16 = idx & 15;
            if (!dry) *(u32x4*)(P + (row0 + r) * ODD_IN + h * 128 + c16 * 8) = *(const LAS u32x4*)(GU + r * 272 + c16 * 16);
        }
        __syncthreads();
    }
}

#define XB_TMO      128
#define XB_XCNT(j)  (256  + 64 * (j))
#define XB_XSUB(j)  (1280 + 64 * (j))
#define XB_XGEN(j)  (2304 + 64 * (j))
#define XB_TOP      3328
#define XB_TOPGEN   3392
#define XCD_BAR_WORDS 3456
#define XB_SPIN_CAP (1u << 18)

__device__ __forceinline__ unsigned xb_ld(unsigned* p)              { return __hip_atomic_load(p, __ATOMIC_RELAXED, __HIP_MEMORY_SCOPE_AGENT); }
__device__ __forceinline__ unsigned xb_add(unsigned* p, unsigned v) { return __hip_atomic_fetch_add(p, v, __ATOMIC_RELAXED, __HIP_MEMORY_SCOPE_AGENT); }
__device__ __forceinline__ unsigned xb_xcc_id() { return (unsigned)__builtin_amdgcn_s_getreg((3 << 11) | 20) & 0xFu; }
#define XB_SPIN(cond, bar) do { unsigned _sp = 0; while (cond) { __builtin_amdgcn_s_sleep(1); \
    if ((++_sp & 255u) == 0u) { if (xb_ld(&(bar)[XB_TMO])) break; if (_sp > XB_SPIN_CAP) { atomicAdd(&(bar)[XB_TMO], 1u); break; } } } } while (0)

struct XcdBarrier {
    unsigned* bar; unsigned x;
    volatile LAS unsigned* st;
};

__device__ __forceinline__ XcdBarrier xcd_barrier_post(unsigned* bar, volatile LAS unsigned* st) {
    XcdBarrier b; b.bar = bar; b.x = xb_xcc_id(); b.st = st;
    if (threadIdx.x == 0) st[2] = xb_add(&bar[XB_XCNT(b.x)], 1u) + 1u;
    return b;
}
__device__ __forceinline__ void xcd_barrier_complete(unsigned* bar, unsigned x, unsigned& nloc, unsigned& nx) {
    const unsigned G = gridDim.x * gridDim.y * gridDim.z;
    unsigned sum, cnt, mine, sp = 0u;
    for (;;) {
        sum = 0u; cnt = 0u; mine = 0u;
#pragma unroll
        for (unsigned j = 0; j < 16; ++j) { const unsigned c = xb_ld(&bar[XB_XCNT(j)]); sum += c; cnt += (c > 0u) ? 1u : 0u; mine = (j == x) ? c : mine; }
        if (sum == G) break;
        __builtin_amdgcn_s_sleep(1);
        if ((++sp & 255u) == 0u) { if (xb_ld(&bar[XB_TMO])) break; if (sp > XB_SPIN_CAP) { atomicAdd(&bar[XB_TMO], 1u); break; } }
    }
    nloc = mine > 0u ? mine : 1u; nx = cnt > 0u ? cnt : 1u;
}

__device__ __forceinline__ void xcd_barrier(const XcdBarrier& b) {
    asm volatile("s_waitcnt vmcnt(0)" ::: "memory");
    __syncthreads();
    if (threadIdx.x == 0) {
        unsigned* bar = b.bar;
        __builtin_amdgcn_s_waitcnt(0);
        unsigned nloc = b.st[0], nx = b.st[1];
        if (nloc == 0u) { xcd_barrier_complete(bar, b.x, nloc, nx); b.st[0] = nloc; b.st[1] = nx; }
        const unsigned old = xb_add(&bar[XB_XSUB(b.x)], 1u);
        const unsigned gen = old / nloc;
        if (old + 1u == (gen + 1u) * nloc) {
            __builtin_amdgcn_fence(__ATOMIC_RELEASE, "agent");
            asm volatile("s_waitcnt vmcnt(0)" ::: "memory");
            const unsigned og = xb_add(&bar[XB_TOP], 1u);
            const unsigned tg = og / nx;
            if (og + 1u == (tg + 1u) * nx) xb_add(&bar[XB_TOPGEN], 1u);
            else XB_SPIN(xb_ld(&bar[XB_TOPGEN]) == tg, bar);
            __builtin_amdgcn_fence(__ATOMIC_ACQUIRE, "agent");
            xb_add(&bar[XB_XGEN(b.x)], 1u);
            asm volatile("s_waitcnt vmcnt(0)" ::: "memory");
        } else {
            XB_SPIN(xb_ld(&bar[XB_XGEN(b.x)]) == gen, bar);
            __builtin_amdgcn_fence(__ATOMIC_ACQUIRE, "agent");
            asm volatile("s_waitcnt vmcnt(0)" ::: "memory");
        }
    }
    __syncthreads();
}

#ifdef DIAG
#define DG(k) (DIAG == (k))
#else
#define DG(k) true
#endif
__global__ void __launch_bounds__(512, 2) fwd_kernel(Args a) {
    extern __shared__ __attribute__((aligned(16))) unsigned char lds_raw[];
    LAS unsigned char* lds = (LAS unsigned char*)lds_raw;
    const int wid = __builtin_amdgcn_readfirstlane(threadIdx.x >> 6);
    const int G = gridDim.x, bx0 = blockIdx.x;
    int bx = bx0;
    unsigned char* ws = a.ws;
    bf16_t* P = (bf16_t*)(ws + WS_P); bf16_t* XB = (bf16_t*)(ws + WS_XB);
    float* SS = (float*)(ws + WS_SS); float* SSV = (float*)(ws + WS_SSV);
    const float* rope = (const float*)(ws + WS_ROPE);
    if (threadIdx.x < 4) ((LAS unsigned*)(lds + BARW_OFF))[threadIdx.x] = 0u;
    __syncthreads();
    XcdBarrier xbar = xcd_barrier_post((unsigned*)(ws + WS_BAR), (volatile LAS unsigned*)(lds + BARW_OFF));
    for (int ph = a.ph_lo; ph < a.ph_hi; ++ph) {
        if (ph > 0 && ((ph - 1) & 3) == 1 && (((ph - 1) >> 2) & 1)) continue;
#ifdef PROBE_KIND
        const int kind = (ph == 0) ? 0 : ((((ph - 1) & 3) == 2) ? ((((ph - 1) >> 2) & 1) ? 3 : 2) : 1);
        const int nrep = (kind == PROBE_KIND && a.ph_lo == 0) ? 2 : 1;
#else
        const int nrep = 1;
#endif
        for (int rep = 0; rep < nrep; ++rep) {
        const bool dry = (rep + 1 < nrep);
        if (rep) { __syncthreads(); cg::this_grid().sync(); }
        int tid = threadIdx.x; asm volatile("" : "+v"(tid));
        const int lane = tid & 63;
        if (ph == 0) {
            if (DG(0)) prologue(a, lds, tid, lane, wid);
            __syncthreads();
        } else {
            const int layer = (ph - 1) >> 2, sub4 = (ph - 1) & 3, j = layer >> 1; const bool even = (layer & 1) == 0;
            const int sub = (sub4 == 0) ? 0 : (sub4 == 1 ? 3 : sub4 - 1);
            if (sub == 3) {
                kprep_phase(P, a.in[7] + j * 64, rope, tid, bx, G);
            } else if (sub == 0) {
                if (even) {
                    pg8::Gemm g{XB, (const bf16_t*)(ws + WS_WINE) + (size_t)j * 2304 * 1024, MTOK, EVEN_IN, 1024, 1024, 0};
                    pg8::StaticOrder S; S.init(MTOK, EVEN_IN, G, bx);
                    pg8::EpiEvenIn E{P, SS, (LAS float*)(lds + RST_OFF)};
                    if (DG(1)) pg8::gemm_phase(lds, g, S, E, tid);
                } else {
                    pg8::Gemm g{XB, (const bf16_t*)(ws + WS_WINO) + (size_t)j * 3072 * 1024, MTOK, ODD_IN, 1024, 1024, 0};
                    pg8::StaticOrder S; S.init(MTOK, ODD_IN, G, bx);
                    pg8::EpiOddIn E{P, SS, SSV, (LAS float*)(lds + RST_OFF)};
                    if (DG(2)) pg8::gemm_phase(lds, g, S, E, tid);
                }
            } else if (sub == 1) {
                if (even) {
                    const int x = bx & 7, y = bx >> 3, gpx = G >> 3;
                    const bool xcdmap = (G % 8 == 0);
                    for (int i = 0;; ++i) {
                        const int v = xcdmap ? ((i * 8 + x) * gpx + y) : (i * G + bx);
                        if (v >= 1536) break;
                        const int grp = v >> 6, w = v & 63;
                        if (DG(3)) attn_unit(lds, P, a.in[6] + j * 64, rope, grp >> 1, (grp & 1) * 4 + (w >> 4), w & 15, lane, wid, dry);
                    }
                    const bf16_t* pwT = (const bf16_t*)(ws + WS_POOLW) + (size_t)j * 4 * 128 * 128;
                    if (DG(4)) pool_run(lds, P, pwT, a.in[5] + j * 512, bx, G, tid, lane, wid, dry);
                } else {
                    const bf16_t* wsb = (const bf16_t*)(ws + WS_WSB) + (size_t)j * 8 * 128 * 128;
                    int hprev = -1;
                    if (G % 8 == 0) {
                        const int h = bx & 7;
                        if (DG(5)) sgu_run(lds, P, wsb, a.in[13] + j * 1024, a.in[11] + j * 1024, SSV, bx >> 3, G >> 3, h, tid, lane, wid, dry);
                    } else {
                        for (int it = bx; it < 3072; it += G) { const int h = it & 7; if (DG(5)) sgu_item(lds, P, wsb, a.in[13] + j * 1024, a.in[11] + j * 1024, SSV, it >> 3, h, h != hprev, tid, lane, wid, dry); hprev = h; }
                    }
                }
            } else {
                if (even) {
                    pg8::Gemm g{P + 512, (const bf16_t*)(ws + WS_WOUTE) + (size_t)j * 1024 * 1024, MTOK, 1024, 1024, EVEN_IN, 1536};
                    pg8::StaticOrder S; S.init(MTOK, 1024, G, bx);
                    pg8::EpiOut E{a.out, layer == 0 ? a.in[0] : a.out, layer == 0 ? a.in[1] - (size_t)MPROMPT * DM : a.out, XB, SS, dry, layer == 3};
                    if (DG(6)) pg8::gemm_phase(lds, g, S, E, tid);
                } else {
                    pg8::Gemm g{P, (const bf16_t*)(ws + WS_WOUTO) + (size_t)j * 1024 * 1024, MTOK, 1024, 1024, ODD_IN, 0};
                    pg8::StaticOrder S; S.init(MTOK, 1024, G, bx);
                    pg8::EpiOut E{a.out, layer == 0 ? a.in[0] : a.out, layer == 0 ? a.in[1] - (size_t)MPROMPT * DM : a.out, XB, SS, dry, layer == 3};
                    if (DG(6)) pg8::gemm_phase(lds, g, S, E, tid);
                }
            }
        }
        }
        if (ph + 1 < a.ph_hi) { if (a.ph_hi > NPHASE) cg::this_grid().sync(); else xcd_barrier(xbar); }
        if (ph == a.ph_lo && ph + 1 < a.ph_hi) {
            volatile LAS unsigned* st = (volatile LAS unsigned*)(lds + BARW_OFF);
            if (threadIdx.x == 0) {
                unsigned* bar = (unsigned*)(ws + WS_BAR); bool ok = (G % 8 == 0) && (xbar.x < 8u);
                for (unsigned jx = 0; jx < 8; ++jx) ok = ok && (xb_ld(&bar[XB_XCNT(jx)]) == (unsigned)(G / 8));
                st[3] = ok ? 1u : 0u;
            }
            __syncthreads();
            if (st[3]) bx = __builtin_amdgcn_readfirstlane((int)xbar.x + 8 * (int)(st[2] - 1u));
        }
    }
}

extern "C" void kernel_launch(void* const* d_in, const int* in_sizes, int n_in, void* d_out, int out_size, void* d_ws, size_t ws_size, hipStream_t stream) {
    static int grid = 0;
    if (grid == 0) {
        if (n_in != 15 || out_size != MTOK * DM || ws_size < WS_END) { fprintf(stderr, "kernel_launch: unexpected shapes (n_in %d out %d ws %zu need %zu)\n", n_in, out_size, ws_size, (size_t)WS_END); grid = -1; return; }
        int dev = 0, cus = 0, per_cu = 0;
        (void)hipGetDevice(&dev);
        (void)hipDeviceGetAttribute(&cus, hipDeviceAttributeMultiprocessorCount, dev);
        if (hipFuncSetAttribute((const void*)fwd_kernel, hipFuncAttributeMaxDynamicSharedMemorySize, LDS_BYTES) != hipSuccess) { fprintf(stderr, "kernel_launch: hipFuncSetAttribute failed\n"); grid = -1; return; }
        if (hipOccupancyMaxActiveBlocksPerMultiprocessor(&per_cu, (const void*)fwd_kernel, 512, LDS_BYTES) != hipSuccess || per_cu < 1) { fprintf(stderr, "kernel_launch: occupancy query gave %d\n", per_cu); per_cu = 1; }
        (void)hipGetLastError();
        grid = cus * per_cu;
        if (grid <= 0) grid = 256;
    }
    if (grid < 0) return;
    (void)hipMemsetAsync((char*)d_ws + WS_BAR, 0, 16384, stream);
    Args a{};
    for (int i = 0; i < 15; ++i) a.in[i] = (const float*)d_in[i];
    a.out = (float*)d_out; a.ws = (unsigned char*)d_ws;
#if N_LAUNCH_MODE == 1
    a.ph_lo = 0; a.ph_hi = NPHASE;
    void* args[] = {&a};
    hipError_t e = hipLaunchCooperativeKernel((const void*)fwd_kernel, dim3(grid), dim3(512), args, LDS_BYTES, stream);
    if (e != hipSuccess) fprintf(stderr, "cooperative launch failed: %s (grid %d)\n", hipGetErrorString(e), grid);
#else
    for (int ph = 0; ph < NPHASE; ++ph) {
        a.ph_lo = ph; a.ph_hi = ph + 1;
        hipLaunchKernelGGL(fwd_kernel, dim3(grid), dim3(512), LDS_BYTES, stream, a);
    }
#endif
}
```

```cpp
#include <hip/hip_runtime.h>
#include <hip/hip_cooperative_groups.h>
#include <cstdio>
#include <cstdint>
namespace cg = cooperative_groups;

#define LAS __attribute__((address_space(3)))
typedef unsigned short bf16_t;
typedef short bf16x8 __attribute__((ext_vector_type(8)));
typedef short s16x4 __attribute__((ext_vector_type(4)));
typedef float f32x2 __attribute__((ext_vector_type(2)));
typedef float f32x4 __attribute__((ext_vector_type(4)));
typedef float f32x16 __attribute__((ext_vector_type(16)));
typedef unsigned u32x2 __attribute__((ext_vector_type(2)));
typedef unsigned u32x4 __attribute__((ext_vector_type(4)));

#ifndef N_LAUNCH_MODE
#define N_LAUNCH_MODE 1
#endif

constexpr int DM = 1024, SEQ = 4096, NSEQ = 12, MTOK = NSEQ * SEQ, MPROMPT = 8 * SEQ;
constexpr int EVEN_IN = 2304, ODD_IN = 3072;
constexpr float EPS = 1e-6f;
constexpr float C2 = 0.125f * 1.4426950408889634f;
constexpr int NPHASE = 17;

constexpr size_t WS_WINE = 0;
constexpr size_t WS_WOUTE = WS_WINE + 2ull * 2304 * 1024 * 2;
constexpr size_t WS_WINO = WS_WOUTE + 2ull * 1024 * 1024 * 2;
constexpr size_t WS_WOUTO = WS_WINO + 2ull * 3072 * 1024 * 2;
constexpr size_t WS_POOLW = WS_WOUTO + 2ull * 1024 * 1024 * 2;
constexpr size_t WS_WSB = WS_POOLW + 2ull * 4 * 128 * 128 * 2;
constexpr size_t WS_ROPE = WS_WSB + 2ull * 8 * 128 * 128 * 2;
constexpr size_t WS_BAR = WS_ROPE + 8192;
constexpr size_t WS_SS = 32ull << 20;
constexpr size_t WS_SSV = WS_SS + (size_t)MTOK * 16 * 4;
constexpr size_t WS_XB = 40ull << 20;
constexpr size_t WS_P = WS_XB + (size_t)MTOK * 1024 * 2;
constexpr size_t WS_END = WS_P + (size_t)MTOK * 3072 * 2;
static_assert(WS_BAR + 16384 <= WS_SS && WS_SSV + (size_t)MTOK * 64 <= WS_XB, "ws map");

constexpr int LDS_BYTES = 159760;
constexpr int BARW_OFF = 159744;
constexpr int XL_OFF = 131072;
constexpr int ROPE_OFF = 139264;
constexpr int RST_OFF = 147456;

__device__ __forceinline__ unsigned cvt_pk_bf16(float lo, float hi) { unsigned r; asm volatile("v_cvt_pk_bf16_f32 %0, %1, %2" : "=v"(r) : "v"(lo), "v"(hi)); return r; }
__device__ __forceinline__ float bflo(unsigned w) { return __uint_as_float(w << 16); }
__device__ __forceinline__ float bfhi(unsigned w) { return __uint_as_float(w & 0xffff0000u); }
__device__ __forceinline__ float silu_f(float v) { return v * __builtin_amdgcn_rcpf(1.f + __builtin_amdgcn_exp2f(-1.4426950408889634f * v)); }
__device__ __forceinline__ float wave_sum(float v) {
#pragma unroll
    for (int o = 1; o < 64; o <<= 1) v += __shfl_xor(v, o);
    return v;
}
#define LDS_WAIT() asm volatile("s_waitcnt lgkmcnt(0)" ::: "memory")
__device__ __forceinline__ f32x2 gelu_pk(f32x2 v) {
    const f32x2 av = __builtin_elementwise_abs(v), d = av * 0.2316418882f + 1.0f;
    f32x2 t; t.x = __builtin_amdgcn_rcpf(d.x); t.y = __builtin_amdgcn_rcpf(d.y);
    f32x2 q = t * 0.5307027145f + (-0.7265760135f); q = q * t + 0.7107068705f; q = q * t + (-0.142248368f); q = q * t + 0.127414796f; q = q * t;
    const f32x2 s = (v * v) * (-0.72134752044f);
    f32x2 e; e.x = __builtin_amdgcn_exp2f(s.x); e.y = __builtin_amdgcn_exp2f(s.y);
    const f32x2 m = v * (q * e), r = v - m;
    f32x2 o; o.x = v.x < 0.f ? m.x : r.x; o.y = v.y < 0.f ? m.y : r.y; return o;
}
__device__ __forceinline__ f32x4 gelu4(f32x4 v) { f32x2 a = gelu_pk((f32x2){v[0], v[1]}), b = gelu_pk((f32x2){v[2], v[3]}); return (f32x4){a.x, a.y, b.x, b.y}; }
__device__ __forceinline__ f32x4 silu4(f32x4 v) { return (f32x4){silu_f(v[0]), silu_f(v[1]), silu_f(v[2]), silu_f(v[3])}; }

__device__ __forceinline__ u32x4 pack8(f32x4 a, f32x4 b) { u32x4 w; w.x = cvt_pk_bf16(a[0], a[1]); w.y = cvt_pk_bf16(a[2], a[3]); w.z = cvt_pk_bf16(b[0], b[1]); w.w = cvt_pk_bf16(b[2], b[3]); return w; }
__device__ __forceinline__ float sq4(f32x4 a) { return (a[0] * a[0] + a[1] * a[1]) + (a[2] * a[2] + a[3] * a[3]); }
__device__ __forceinline__ float fq_sum(float s) {
    const auto a = __builtin_amdgcn_permlane16_swap(__float_as_uint(s), __float_as_uint(s), false, false);
    const float t = __uint_as_float(a[0]) + __uint_as_float(a[1]);
    const auto b = __builtin_amdgcn_permlane32_swap(__float_as_uint(t), __float_as_uint(t), false, false);
    return __uint_as_float(b[0]) + __uint_as_float(b[1]);
}
__device__ __forceinline__ float xor32(float v, bool lo) {
    const auto a = __builtin_amdgcn_permlane32_swap(__float_as_uint(v), __float_as_uint(v), false, false);
    return __uint_as_float(lo ? a[1] : a[0]);
}
__device__ __forceinline__ float row_rstd(const float* ss, int row, int fq) {
    const f32x4 p = *(const f32x4*)(ss + (size_t)row * 16 + 4 * fq);
    const float s = fq_sum((p[0] + p[1]) + (p[2] + p[3]));
    return __builtin_amdgcn_rsqf(s * (1.0f / 1024.0f) + EPS);
}

__device__ __forceinline__ void store_rows64(LAS unsigned char* st, bf16_t* base, size_t pitch, u32x4 val, int fr, int fq, int lane) {
    *(LAS u32x4*)(st + fr * 80 + fq * 16) = val;
    const u32x4 t = *(const LAS u32x4*)(st + (lane >> 2) * 80 + (lane & 3) * 16);
    *(u32x4*)(base + (size_t)(lane >> 2) * pitch + (lane & 3) * 8) = t;
}
namespace pg8 {
constexpr int BM = 256, BK = 64, HALF = 128, HTB = HALF * BK * 2, STAGE_BYTES = 8 * HTB, NXCD = 8, WGM = 8;
__host__ __device__ __forceinline__ int lds_byte(int r, int c) { const int st = (r >> 4) * 2 + (c >> 5), rr = r & 15, cc = c & 31, ob = rr * 64 + cc * 2; return st * 1024 + (ob ^ (((ob >> 9) & 1) << 5)); }
__host__ __device__ __forceinline__ void stage_rc(int b, int& R, int& C) { const int st = b / 1024, sb = b % 1024, swz = sb ^ (((sb >> 9) & 1) << 5); R = (st >> 1) * 16 + swz / 64; C = (st & 1) * 32 + (swz % 64) / 2; }
__host__ __device__ __forceinline__ int perm32(int rho) { const int n = rho >> 4, i = rho & 15; return 8 * (i >> 2) + 4 * n + (i & 3); }

struct Unit { int pm, pn; };
struct Gemm { const bf16_t* A; const bf16_t* Bt; int M, N, K, lda, xtra; };

struct StaticOrder {
    int nM, nN, nwg, G, c;
    __host__ __device__ void init(int M, int N, int G_, int c_) { nM = M / BM; nN = N / BM; nwg = nM * nN; G = G_; c = c_; }
    __host__ __device__ bool next(int i, Unit& u) const {
        const long L = (long)i * G + c; if (L >= nwg) return false;
        int wgid = (int)L; { const int q = nwg / NXCD, r = nwg % NXCD, xcd = wgid % NXCD, off = wgid / NXCD; wgid = (xcd < r ? xcd * (q + 1) : r * (q + 1) + (xcd - r) * q) + off; }
        const int nig = WGM * nN, gid = wgid / nig, fm = gid * WGM, gsz = (nM - fm) < WGM ? (nM - fm) : WGM;
        u.pm = fm + ((wgid % nig) % gsz); u.pn = (wgid % nig) / gsz; return true;
    }
};

template <class Epi>
__device__ __forceinline__ void gemm_phase(LAS unsigned char* lds, const Gemm g, const StaticOrder& S, const Epi& E, const int tid) {
    const int wid = __builtin_amdgcn_readfirstlane(tid >> 6), lane = tid & 63, wr = wid >> 2, wc = wid & 3, fr = lane & 15, fq = lane >> 4;
    const int K = g.K, nt = K / BK, lda = g.lda;
    unsigned voffA[2], voffB[2];
#pragma unroll
    for (int i = 0; i < 2; ++i) { int R, C; stage_rc(tid * 16 + i * 8192, R, C); const int Rb = (R & ~31) + perm32(R & 31);
        voffA[i] = (unsigned)(R * lda + C) * 2u; voffB[i] = (unsigned)(Rb * K + C) * 2u; }
    const size_t kstep = (size_t)(BK * 2);
    const size_t hstepA = (size_t)HALF * lda * 2, tstepA = 2 * hstepA;
    const size_t hstepB = (size_t)HALF * K * 2, tstepB = 2 * hstepB;
    const size_t xtra = (size_t)g.xtra;
    const unsigned ldsw = (unsigned)wid * 1024u;
    const int aoff = lds_byte(wr * 64 + fr, fq * 8), boff = lds_byte(wc * 32 + fr, fq * 8);
#define PG8_SA(b, h) (((b) * 2 + (h)) * HTB)
#define PG8_SB(b, h) ((4 + (b) * 2 + (h)) * HTB)
#define PG8_STAGE(bufoff, gbase, voff) do { _Pragma("unroll") for (int _i = 0; _i < 2; ++_i) \
        __builtin_amdgcn_global_load_lds((const unsigned*)((const char*)(gbase) + (voff)[_i]), (LAS unsigned*)(lds + (bufoff) + ldsw + _i * 8192), 16, 0, 0); } while (0)
#define PG8_LDA(dst, b, h) do { _Pragma("unroll") for (int m = 0; m < 4; ++m) _Pragma("unroll") for (int k = 0; k < 2; ++k) dst[m][k] = *(const LAS bf16x8*)(lds + PG8_SA(b, h) + aoff + m * 2048 + k * 1024); } while (0)
#define PG8_LDB(dst, b, h) do { _Pragma("unroll") for (int n = 0; n < 2; ++n) _Pragma("unroll") for (int k = 0; k < 2; ++k) dst[n][k] = *(const LAS bf16x8*)(lds + PG8_SB(b, h) + boff + n * 2048 + k * 1024); } while (0)
#define PG8_MMA(ai, bj, At, Bt) do { __builtin_amdgcn_s_setprio(1); _Pragma("unroll") for (int m = 0; m < 4; ++m) _Pragma("unroll") for (int n = 0; n < 2; ++n) _Pragma("unroll") for (int k = 0; k < 2; ++k) \
        acc[ai][bj][m][n] = __builtin_amdgcn_mfma_f32_16x16x32_bf16(Bt[n][k], At[m][k], acc[ai][bj][m][n], 0, 0, 0); __builtin_amdgcn_s_setprio(0); } while (0)
#define PG8_WAIT_V(n) asm volatile("s_waitcnt vmcnt(" #n ")" ::: "memory")
#define PG8_WAIT_L(n) asm volatile("s_waitcnt lgkmcnt(" #n ")" ::: "memory")
#define PG8_BAR __builtin_amdgcn_s_barrier()
#define PG8_SCHED __builtin_amdgcn_sched_barrier(0)
    Unit cur, nxt; int ui = 0;
    if (!S.next(0, cur)) return;
    f32x4 acc[2][2][4][2];
#pragma unroll
    for (int a = 0; a < 2; ++a)
#pragma unroll
        for (int b = 0; b < 2; ++b)
#pragma unroll
            for (int m = 0; m < 4; ++m)
#pragma unroll
                for (int n = 0; n < 2; ++n) acc[a][b][m][n] = (f32x4){0.f, 0.f, 0.f, 0.f};
    bf16x8 At[4][2], B0[2][2], B1[2][2];
    const char* cA = (const char*)g.A + (size_t)cur.pm * tstepA; const char* cB = (const char*)g.Bt + (size_t)cur.pn * tstepB;
    f32x4 pf[2];
    E.pre(cur.pm, tid, pf); E.post(0, tid, pf);
    PG8_STAGE(PG8_SB(0, 0), cB, voffB); PG8_STAGE(PG8_SB(0, 1), cB + hstepB, voffB); PG8_STAGE(PG8_SA(0, 0), cA, voffA); PG8_STAGE(PG8_SA(0, 1), cA + hstepA, voffA);
    if (wr == 1) PG8_BAR;
    PG8_WAIT_V(2); PG8_BAR;
    PG8_STAGE(PG8_SB(1, 0), cB + kstep, voffB); PG8_STAGE(PG8_SA(1, 0), cA + kstep, voffA); PG8_STAGE(PG8_SB(1, 1), cB + hstepB + kstep, voffB);
    PG8_WAIT_V(6); PG8_BAR;
    for (;;) {
        const bool has_next = S.next(ui + 1, nxt);
        const char* nA = has_next ? (const char*)g.A + (size_t)nxt.pm * tstepA : cA; const char* nB = has_next ? (const char*)g.Bt + (size_t)nxt.pn * tstepB : cB;
        for (int t = 0; t < nt; t += 2) {
            const bool last = (t == nt - 2);
            const char* a1 = cA + (size_t)(t + 1) * kstep + ((t + 1) >= 8 ? xtra : 0);
            const char* a2 = last ? nA : cA + (size_t)(t + 2) * kstep + ((t + 2) >= 8 ? xtra : 0); const char* b2 = last ? nB : cB + (size_t)(t + 2) * kstep;
            const char* a3 = a2 + kstep; const char* b3 = b2 + kstep;
            PG8_LDB(B0, 0, 0); PG8_LDB(B1, 0, 1); PG8_SCHED; PG8_LDA(At, 0, 0); PG8_STAGE(PG8_SA(1, 1), a1 + hstepA, voffA);
            PG8_WAIT_V(8); PG8_WAIT_L(0); PG8_BAR; PG8_MMA(0, 0, At, B0); PG8_MMA(0, 1, At, B1); PG8_BAR; PG8_SCHED;
            PG8_LDA(At, 0, 1); PG8_STAGE(PG8_SB(0, 0), b2, voffB); PG8_STAGE(PG8_SB(0, 1), b2 + hstepB, voffB); PG8_STAGE(PG8_SA(0, 0), a2, voffA);
            PG8_WAIT_V(8); PG8_WAIT_L(0); PG8_BAR; PG8_MMA(1, 0, At, B0); PG8_MMA(1, 1, At, B1); PG8_BAR; PG8_SCHED;
            PG8_LDB(B0, 1, 0); PG8_LDB(B1, 1, 1); PG8_SCHED; PG8_LDA(At, 1, 0); PG8_STAGE(PG8_SA(0, 1), a2 + hstepA, voffA);
            PG8_WAIT_V(8); PG8_WAIT_L(0); PG8_BAR; PG8_MMA(0, 0, At, B0); PG8_MMA(0, 1, At, B1); PG8_BAR; PG8_SCHED;
            PG8_LDA(At, 1, 1); PG8_STAGE(PG8_SB(1, 0), b3, voffB); PG8_STAGE(PG8_SB(1, 1), b3 + hstepB, voffB); PG8_STAGE(PG8_SA(1, 0), a3, voffA);
            PG8_WAIT_V(8); PG8_WAIT_L(0); PG8_BAR; PG8_MMA(1, 0, At, B0); PG8_MMA(1, 1, At, B1); PG8_BAR; PG8_SCHED;
        }
        if (wr == 0) PG8_BAR;
        if (has_next) E.pre(nxt.pm, tid, pf);
        E(acc, cur, wr, wc, fr, fq, ui & 1);
        if (has_next) E.post((ui + 1) & 1, tid, pf);
        if (!has_next) break;
#pragma unroll
        for (int a = 0; a < 2; ++a)
#pragma unroll
            for (int b = 0; b < 2; ++b)
#pragma unroll
                for (int m = 0; m < 4; ++m)
#pragma unroll
                    for (int n = 0; n < 2; ++n) acc[a][b][m][n] = (f32x4){0.f, 0.f, 0.f, 0.f};
        cur = nxt; cA = nA; cB = nB; ++ui;
        if (wr == 1) PG8_BAR;
    }
    PG8_WAIT_V(0);
    PG8_BAR;
#undef PG8_SA
#undef PG8_SB
#undef PG8_STAGE
#undef PG8_LDA
#undef PG8_LDB
#undef PG8_MMA
#undef PG8_WAIT_V
#undef PG8_WAIT_L
#undef PG8_BAR
#undef PG8_SCHED
}

struct EpiEvenIn {
    bf16_t* P; const float* ss; LAS float* rst;
    __device__ __forceinline__ void pre(int pm, int tid, f32x4 (&r)[2]) const {
        const float* p = ss + ((size_t)pm * BM + (tid >> 1)) * 16 + 8 * (tid & 1);
        r[0] = *(const f32x4*)p; r[1] = *(const f32x4*)(p + 4);
    }
    __device__ __forceinline__ void post(int slot, int tid, const f32x4 (&r)[2]) const {
        const f32x4 t = r[0] + r[1]; float s = (t[0] + t[1]) + (t[2] + t[3]);
        s += __shfl_xor(s, 1);
        if ((tid & 1) == 0) rst[slot * 256 + (tid >> 1)] = __builtin_amdgcn_rsqf(s * (1.0f / 1024.0f) + EPS);
    }
    __device__ __forceinline__ void operator()(const f32x4 (&acc)[2][2][4][2], const Unit& u, int wr, int wc, int fr_, int fq_, int slot) const {
        int fr = fr_, fq = fq_; asm volatile("" : "+v"(fr), "+v"(fq));
        const int pn = u.pn;
        const int col0 = pn * BM + wc * 32 + 8 * fq;
        float rs[2][4];
#pragma unroll
        for (int ai = 0; ai < 2; ++ai)
#pragma unroll
            for (int m = 0; m < 4; ++m) rs[ai][m] = rst[slot * 256 + ai * HALF + wr * 64 + m * 16 + fr];
#pragma unroll
        for (int ai = 0; ai < 2; ++ai)
#pragma unroll
            for (int m = 0; m < 4; ++m) {
                bf16_t* rowp = P + (size_t)(u.pm * BM + ai * HALF + wr * 64 + m * 16 + fr) * EVEN_IN + col0;
#pragma unroll
                for (int bj = 0; bj < 2; ++bj) {
                    f32x4 v0 = acc[ai][bj][m][0] * rs[ai][m], v1 = acc[ai][bj][m][1] * rs[ai][m];
                    *(u32x4*)(rowp + bj * HALF) = pack8(v0, v1);
                }
                asm volatile("" ::: "memory");
            }
    }
};

struct EpiOddIn {
    bf16_t* P; const float* ss; float* ssv; LAS float* rst;
    __device__ __forceinline__ void pre(int pm, int tid, f32x4 (&r)[2]) const {
        const float* p = ss + ((size_t)pm * BM + (tid >> 1)) * 16 + 8 * (tid & 1);
        r[0] = *(const f32x4*)p; r[1] = *(const f32x4*)(p + 4);
    }
    __device__ __forceinline__ void post(int slot, int tid, const f32x4 (&r)[2]) const {
        const f32x4 t = r[0] + r[1]; float s = (t[0] + t[1]) + (t[2] + t[3]);
        s += __shfl_xor(s, 1);
        if ((tid & 1) == 0) rst[slot * 256 + (tid >> 1)] = __builtin_amdgcn_rsqf(s * (1.0f / 1024.0f) + EPS);
    }
    __device__ __forceinline__ void operator()(const f32x4 (&acc)[2][2][4][2], const Unit& u, int wr, int wc, int fr_, int fq_, int slot) const {
        int fr = fr_, fq = fq_; asm volatile("" : "+v"(fr), "+v"(fq));
        const int pn = u.pn, col0 = pn * BM + wc * 32 + 8 * fq;
        float rs[2][4];
#pragma unroll
        for (int ai = 0; ai < 2; ++ai)
#pragma unroll
            for (int m = 0; m < 4; ++m) rs[ai][m] = rst[slot * 256 + ai * HALF + wr * 64 + m * 16 + fr];
#pragma unroll
        for (int ai = 0; ai < 2; ++ai)
#pragma unroll
            for (int m = 0; m < 4; ++m) {
                const int row = u.pm * BM + ai * HALF + wr * 64 + m * 16 + fr;
                const float r = rs[ai][m];
                bf16_t* rowp = P + (size_t)row * ODD_IN + col0;
                float sq = 0.f;
#pragma unroll
                for (int bj = 0; bj < 2; ++bj) {
                    f32x4 v0 = acc[ai][bj][m][0] * r, v1 = acc[ai][bj][m][1] * r;
                    if (pn >= 4 && pn < 8) { v0 = gelu4(v0); v1 = gelu4(v1); sq += sq4(v0) + sq4(v1); }
                    *(u32x4*)(rowp + bj * HALF) = pack8(v0, v1);
                }
                if (pn >= 4 && pn < 8) { sq = fq_sum(sq); if (fq == 0) ssv[(size_t)row * 16 + (pn - 4) * 4 + wc] = sq; }
                asm volatile("" ::: "memory");
            }
    }
};

struct EpiOut {
    float* X; const float* R0; const float* R1; bf16_t* XB; float* ss; bool dry; bool lastl;
    __device__ __forceinline__ void pre(int, int, f32x4 (&)[2]) const {}
    __device__ __forceinline__ void post(int, int, const f32x4 (&)[2]) const {}
    __device__ __forceinline__ void load2(f32x4 (&xv)[2][2][2], const float* rb, int b) const {
#pragma unroll
        for (int mm = 0; mm < 2; ++mm) {
            const float* xp = rb + (size_t)((b >> 1) * HALF + (2 * (b & 1) + mm) * 16) * DM;
#pragma unroll
            for (int bj = 0; bj < 2; ++bj) { xv[mm][bj][0] = *(const f32x4*)(xp + bj * HALF); xv[mm][bj][1] = *(const f32x4*)(xp + bj * HALF + 4); }
        }
    }
    __device__ __forceinline__ void operator()(const f32x4 (&acc)[2][2][4][2], const Unit& u, int wr, int wc, int fr_, int fq_, int slot) const {
        int fr = fr_, fq = fq_; asm volatile("" : "+v"(fr), "+v"(fq));
        const int pn = u.pn, col0 = pn * BM + wc * 32 + 8 * fq;
        const float* rb = ((u.pm * BM < MPROMPT) ? R0 : R1) + (size_t)(u.pm * BM + wr * 64 + fr) * DM + col0;
        f32x4 xa[2][2][2], xb2[2][2][2];
        load2(xa, rb, 0);
#pragma unroll
        for (int b = 0; b < 4; ++b) {
            if (b + 1 < 4) { if (b & 1) load2(xa, rb, b + 1); else load2(xb2, rb, b + 1); }
            const int ai = b >> 1;
#pragma unroll
            for (int mm = 0; mm < 2; ++mm) {
                const int m = 2 * (b & 1) + mm;
                const int row = u.pm * BM + ai * HALF + wr * 64 + m * 16 + fr;
                float* xp = X + (size_t)row * DM + col0; bf16_t* bp = XB + (size_t)row * DM + col0;
                float sq = 0.f;
#pragma unroll
                for (int bj = 0; bj < 2; ++bj) {
                    const f32x4 x0 = ((b & 1) ? xb2[mm][bj][0] : xa[mm][bj][0]) + acc[ai][bj][m][0], x1 = ((b & 1) ? xb2[mm][bj][1] : xa[mm][bj][1]) + acc[ai][bj][m][1];
                    if (!dry) { *(f32x4*)(xp + bj * HALF) = x0; *(f32x4*)(xp + bj * HALF + 4) = x1;
                    if (!lastl) *(u32x4*)(bp + bj * HALF) = pack8(x0, x1); }
                    sq += sq4(x0) + sq4(x1);
                }
                if (!lastl) { sq = fq_sum(sq); if (fq == 0 && !dry) ss[(size_t)row * 16 + pn * 4 + wc] = sq; }
            }
        }
    }
};
}

__device__ __forceinline__ void p0_transpose_item(const float* W, int K, int N, bf16_t* WT, const float* gk, LAS float* scr, int item, int lane) {
    const int nblk = N / 32, kb = item / nblk, nb = item % nblk, k0 = 64 * kb, n0 = 32 * nb;
#pragma unroll
    for (int i = 0; i < 8; ++i) {
        const int kk = 8 * i + (lane >> 3); f32x4 v = *(const f32x4*)(W + (size_t)(k0 + kk) * N + n0 + 4 * (lane & 7));
        if (gk) v = v * gk[k0 + kk];
        LAS float* d = scr + kk * 33 + 4 * (lane & 7); d[0] = v[0]; d[1] = v[1]; d[2] = v[2]; d[3] = v[3];
    }
    LDS_WAIT(); asm volatile("" ::: "memory");
    const int c = lane & 7;
#pragma unroll
    for (int j = 0; j < 4; ++j) { const int n = (lane >> 3) + 8 * j; const LAS float* s = scr + (8 * c) * 33 + n;
        u32x4 o; o.x = cvt_pk_bf16(s[0 * 33], s[1 * 33]); o.y = cvt_pk_bf16(s[2 * 33], s[3 * 33]); o.z = cvt_pk_bf16(s[4 * 33], s[5 * 33]); o.w = cvt_pk_bf16(s[6 * 33], s[7 * 33]);
        *(u32x4*)(WT + (size_t)(n0 + n) * K + k0 + 8 * c) = o; }
    LDS_WAIT(); asm volatile("" ::: "memory");
}

struct Args { const float* in[15]; float* out; unsigned char* ws; int ph_lo, ph_hi; };

__device__ __forceinline__ void prologue(const Args& a, LAS unsigned char* lds, int tid, int lane, int wid) {
    unsigned char* ws = a.ws;
    const int G = gridDim.x, gw = blockIdx.x * 8 + wid, NGW = G * 8;
    LAS float* scr = (LAS float*)(lds + wid * 16384);
    constexpr int I_INE = 16 * 72, I_OUT = 16 * 32, I_INO = 16 * 96, I_POOL = 2 * 4;
    constexpr int NITEMS = 2 * (I_INE + I_OUT + I_INO + I_OUT) + 8 * I_POOL;
    for (int it = gw; it < NITEMS; it += NGW) {
        int r = it;
        if (r < 2 * I_INE) { const int j = r / I_INE; p0_transpose_item(a.in[3] + (size_t)j * 1024 * 2304, 1024, 2304, (bf16_t*)(ws + WS_WINE) + (size_t)j * 2304 * 1024, a.in[2] + j * 1024, scr, r % I_INE, lane); continue; } r -= 2 * I_INE;
        if (r < 2 * I_OUT) { const int j = r / I_OUT; p0_transpose_item(a.in[8] + (size_t)j * 1024 * 1024, 1024, 1024, (bf16_t*)(ws + WS_WOUTE) + (size_t)j * 1024 * 1024, nullptr, scr, r % I_OUT, lane); continue; } r -= 2 * I_OUT;
        if (r < 2 * I_INO) { const int j = r / I_INO; p0_transpose_item(a.in[10] + (size_t)j * 1024 * 3072, 1024, 3072, (bf16_t*)(ws + WS_WINO) + (size_t)j * 3072 * 1024, a.in[9] + j * 1024, scr, r % I_INO, lane); continue; } r -= 2 * I_INO;
        if (r < 2 * I_OUT) { const int j = r / I_OUT; p0_transpose_item(a.in[14] + (size_t)j * 1024 * 1024, 1024, 1024, (bf16_t*)(ws + WS_WOUTO) + (size_t)j * 1024 * 1024, nullptr, scr, r % I_OUT, lane); continue; } r -= 2 * I_OUT;
        { const int mt = r / I_POOL; p0_transpose_item(a.in[4] + (size_t)mt * 128 * 128, 128, 128, (bf16_t*)(ws + WS_POOLW) + (size_t)mt * 128 * 128, nullptr, scr, r % I_POOL, lane); }
    }
    { const float* wsf = a.in[12]; bf16_t* dst = (bf16_t*)(ws + WS_WSB);
      for (int i = (blockIdx.x * 512 + tid) * 4; i < 2 * 8 * 128 * 128; i += G * 512 * 4) { const f32x4 v = *(const f32x4*)(wsf + i); u32x2 o; o.x = cvt_pk_bf16(v[0], v[1]); o.y = cvt_pk_bf16(v[2], v[3]); *(u32x2*)(dst + i) = o; } }
    { float* rope = (float*)(ws + WS_ROPE);
      for (int i = blockIdx.x * 512 + tid; i < 1024; i += G * 512) { const int idx = i >> 4, f = i & 15; const float inv = 1.0f / powf(10000.0f, (float)f / 16.0f); const float ang = (float)idx * inv; rope[i] = cosf(ang); rope[1024 + i] = sinf(ang); } }
    { const float* xp = a.in[0]; const float* xs = a.in[1]; float* ss = (float*)(ws + WS_SS); bf16_t* xb = (bf16_t*)(ws + WS_XB);
      for (int m = gw; m < MTOK; m += NGW) {
          const float* src = (m < MPROMPT) ? xp + (size_t)m * DM : xs + (size_t)(m - MPROMPT) * DM;
          f32x4 v[4]; float s = 0.f;
#pragma unroll
          for (int j = 0; j < 4; ++j) { v[j] = *(const f32x4*)(src + (lane + 64 * j) * 4); s += sq4(v[j]); }
          s = wave_sum(s);
#pragma unroll
          for (int j = 0; j < 4; ++j) { u32x2 o; o.x = cvt_pk_bf16(v[j][0], v[j][1]); o.y = cvt_pk_bf16(v[j][2], v[j][3]); *(u32x2*)(xb + (size_t)m * DM + (lane + 64 * j) * 4) = o; }
          if (lane < 16) ss[(size_t)m * 16 + lane] = (lane == 0) ? s : 0.f;
      } }
}

__device__ __forceinline__ void kprep_item(bf16_t* P, const float* kg, const float* rope, int idx, const u32x4 w) {
    const int e8 = idx & 7, hk = (idx >> 3) & 1, row = idx >> 4;
    float x[8] = {bflo(w.x), bfhi(w.x), bflo(w.y), bfhi(w.y), bflo(w.z), bfhi(w.z), bflo(w.w), bfhi(w.w)};
    float ssq = 0.f;
#pragma unroll
    for (int e = 0; e < 8; ++e) ssq += x[e] * x[e];
    ssq += __shfl_xor(ssq, 1); ssq += __shfl_xor(ssq, 2); ssq += __shfl_xor(ssq, 4);
    const float rh = __builtin_amdgcn_rsqf(ssq * (1.0f / 64.0f) + EPS);
    const int t = row & (SEQ - 1), ir = (e8 < 4) ? (t >> 6) : (t & 63), f0 = 8 * (e8 & 1);
    const f32x4 g0 = *(const f32x4*)(kg + e8 * 8), g1 = *(const f32x4*)(kg + e8 * 8 + 4);
    const f32x4 c0 = *(const f32x4*)(rope + ir * 16 + f0), c1 = *(const f32x4*)(rope + ir * 16 + f0 + 4);
    const f32x4 s0 = *(const f32x4*)(rope + 1024 + ir * 16 + f0), s1 = *(const f32x4*)(rope + 1024 + ir * 16 + f0 + 4);
    const float sgn = (e8 & 2) ? 1.0f : -1.0f;
    float o[8];
#pragma unroll
    for (int e = 0; e < 8; ++e) {
        const float y = x[e] * rh * (e < 4 ? g0[e & 3] : g1[e & 3]);
        const float other = __shfl_xor(y, 2);
        o[e] = y * (e < 4 ? c0[e & 3] : c1[e & 3]) + sgn * other * (e < 4 ? s0[e & 3] : s1[e & 3]);
    }
    u32x4 r; r.x = cvt_pk_bf16(o[0], o[1]); r.y = cvt_pk_bf16(o[2], o[3]); r.z = cvt_pk_bf16(o[4], o[5]); r.w = cvt_pk_bf16(o[6], o[7]);
    *(u32x4*)(P + (size_t)row * EVEN_IN + 1536 + hk * 64 + e8 * 8) = r;
}
__device__ __forceinline__ void kprep_phase(bf16_t* P, const float* kg, const float* rope, int tid, int bx, int G) {
    const int stride = G * 512;
    for (int base = bx * 512 + tid; base < MTOK * 16; base += 3 * stride) {
        u32x4 w[3];
#pragma unroll
        for (int q = 0; q < 3; ++q) { const int idx = base + q * stride; if (idx < MTOK * 16) w[q] = *(const u32x4*)(P + (size_t)(idx >> 4) * EVEN_IN + 1536 + ((idx >> 3) & 1) * 64 + (idx & 7) * 8); }
#pragma unroll
        for (int q = 0; q < 3; ++q) { const int idx = base + q * stride; if (idx < MTOK * 16) kprep_item(P, kg, rope, idx, w[q]); }
    }
}

#define MFMA32(a, b, c) __builtin_amdgcn_mfma_f32_32x32x16_bf16(a, b, c, 0, 0, 0)
#define MFMA16(a, b, c) __builtin_amdgcn_mfma_f32_16x16x32_bf16(a, b, c, 0, 0, 0)
__device__ __forceinline__ s16x4 vtr(const LAS unsigned char* p) { return __builtin_bit_cast(s16x4, __builtin_amdgcn_ds_read_tr16_b64_v4i16((LAS s16x4*)p)); }
__device__ __forceinline__ float max3f(float a, float b, float c) { return __builtin_fmaxf(__builtin_fmaxf(a, b), c); }

#define ABAR() asm volatile("s_waitcnt lgkmcnt(0)\n\ts_barrier" ::: "memory")
#define SGB(mask, n) __builtin_amdgcn_sched_group_barrier(mask, n, 0)
typedef __bf16 bf16v2 __attribute__((ext_vector_type(2)));
__device__ __forceinline__ unsigned cvtpk(float a, float b) { const bf16v2 r = __builtin_convertvector((f32x2){a, b}, bf16v2); return __builtin_bit_cast(unsigned, r); }
__device__ __forceinline__ float pairmax(float m) { auto rr = __builtin_amdgcn_permlane32_swap(__float_as_uint(m), __float_as_uint(m), false, false); return __builtin_fmaxf(__uint_as_float(rr[0]), __uint_as_float(rr[1])); }
__device__ __forceinline__ float rowmax32(const f32x16& p0, const f32x16& p1) {
    float a = max3f(p0[0], p0[1], p1[0]), b = max3f(p0[2], p0[3], p1[1]); a = max3f(a, p1[2], p1[3]);
#pragma unroll
    for (int r = 4; r < 16; r += 4) { a = max3f(a, p0[r], p0[r + 1]); b = max3f(b, p0[r + 2], p0[r + 3]); a = max3f(a, p1[r], p1[r + 1]); b = max3f(b, p1[r + 2], p1[r + 3]); }
    return pairmax(__builtin_fmaxf(a, b));
}
#define SBAR() __builtin_amdgcn_sched_barrier(0)
#define PIN(x) asm volatile("" : "+v"(x))
#define VCHUNK(PC, KB, R) do { \
        float e0_ = __builtin_amdgcn_exp2f(PC[(R)]), e1_ = __builtin_amdgcn_exp2f(PC[(R) + 1]), e2_ = __builtin_amdgcn_exp2f(PC[(R) + 2]), e3_ = __builtin_amdgcn_exp2f(PC[(R) + 3]); \
        s0 += e0_; s1 += e1_; s2 += e2_; s3 += e3_; pw[KB][(R) / 2] = cvtpk(e0_, e1_); pw[KB][(R) / 2 + 1] = cvtpk(e2_, e3_); \
        PIN(pw[KB][(R) / 2]); PIN(pw[KB][(R) / 2 + 1]); PIN(s0); PIN(s1); PIN(s2); PIN(s3); } while (0)
#define VTR4(J) do { const LAS unsigned char* vb_ = vc + (J) * 1024; va0 = vtr(vb_); va1 = vtr(vb_ + 512); vb0 = vtr(vb_ + 4096); vb1 = vtr(vb_ + 4096 + 512); } while (0)
#define PVJ(J) do { const u32x4 pbw_ = {pw[(J) >> 1][4 * ((J) & 1)], pw[(J) >> 1][4 * ((J) & 1) + 1], pw[(J) >> 1][4 * ((J) & 1) + 2], pw[(J) >> 1][4 * ((J) & 1) + 3]}; \
        const bf16x8 pb_ = __builtin_bit_cast(bf16x8, pbw_); \
        const bf16x8 fa_ = {va0[0], va0[1], va0[2], va0[3], va1[0], va1[1], va1[2], va1[3]}; const bf16x8 fb_ = {vb0[0], vb0[1], vb0[2], vb0[3], vb1[0], vb1[1], vb1[2], vb1[3]}; \
        o0 = MFMA32(fa_, pb_, o0); o1 = MFMA32(fb_, pb_, o1); } while (0)
#define ASTEP(T, PC0, PC1, PN0, PN1, KRO, VRO, KRN, VRN) do { \
        const int t_ = (T); \
        if (t_ + 3 < NT) KRN = *(const u32x4*)(ksrc + (size_t)(t_ + 3) * 64 * EVEN_IN); \
        if (t_ + 2 < NT) VRN = *(const u32x4*)(vsrc + (size_t)(t_ + 2) * 64 * EVEN_IN); \
        const LAS unsigned char* kn = lds + ((t_ + 1) & 1) * 8192 + koff; \
        const LAS unsigned char* vc = lds + (t_ & 1) * 8192 + voff; \
        bf16x8 kf[8]; \
        _Pragma("unroll") for (int d0 = 0; d0 < 4; ++d0) { kf[2 * d0] = *(const LAS bf16x8*)(kn + d0 * 2048); kf[2 * d0 + 1] = *(const LAS bf16x8*)(kn + d0 * 2048 + 512); } \
        unsigned pw[2][8]; float s0 = 0.f, s1 = 0.f, s2 = 0.f, s3 = 0.f; s16x4 va0, va1, vb0, vb1; \
        SBAR(); \
        VCHUNK(PC0, 0, 0); VCHUNK(PC1, 1, 0); SBAR(); \
        PN0 = MFMA32(kf[0], qf[0], negm); VCHUNK(PC0, 0, 4); SBAR(); \
        PN1 = MFMA32(kf[1], qf[0], negm); VCHUNK(PC1, 1, 4); SBAR(); \
        PN0 = MFMA32(kf[2], qf[1], PN0); VCHUNK(PC0, 0, 8); SBAR(); \
        PN1 = MFMA32(kf[3], qf[1], PN1); VCHUNK(PC1, 1, 8); SBAR(); \
        PN0 = MFMA32(kf[4], qf[2], PN0); VCHUNK(PC0, 0, 12); SBAR(); \
        PN1 = MFMA32(kf[5], qf[2], PN1); VCHUNK(PC1, 1, 12); SBAR(); \
        PN0 = MFMA32(kf[6], qf[3], PN0); VTR4(0); lsum += (s0 + s1) + (s2 + s3); SBAR(); \
        PN1 = MFMA32(kf[7], qf[3], PN1); SBAR(); \
        PVJ(0); VTR4(1); \
        float ma_ = max3f(PN0[0], PN0[1], PN0[2]); ma_ = max3f(ma_, PN0[3], PN0[4]); ma_ = max3f(ma_, PN0[5], PN0[6]); ma_ = max3f(ma_, PN0[7], PN0[8]); PIN(ma_); SBAR(); \
        PVJ(1); VTR4(2); \
        ma_ = max3f(ma_, PN0[9], PN0[10]); ma_ = max3f(ma_, PN0[11], PN0[12]); ma_ = max3f(ma_, PN0[13], PN0[14]); ma_ = max3f(ma_, PN0[15], PN1[0]); PIN(ma_); SBAR(); \
        PVJ(2); VTR4(3); \
        float mb_ = max3f(PN1[1], PN1[2], PN1[3]); mb_ = max3f(mb_, PN1[4], PN1[5]); mb_ = max3f(mb_, PN1[6], PN1[7]); mb_ = max3f(mb_, PN1[8], PN1[9]); PIN(mb_); SBAR(); \
        PVJ(3); \
        mb_ = max3f(mb_, PN1[10], PN1[11]); mb_ = max3f(mb_, PN1[12], PN1[13]); mb_ = max3f(mb_, PN1[14], PN1[15]); \
        const float mt_ = pairmax(__builtin_fmaxf(ma_, mb_)); \
        SBAR(); \
        if (t_ + 2 < NT) *(LAS u32x4*)(lds + (t_ & 1) * 8192 + kdst) = KRO; \
        if (t_ + 1 < NT) *(LAS u32x4*)(lds + ((t_ + 1) & 1) * 8192 + vdst) = VRO; \
        if (__builtin_amdgcn_ballot_w64(mt_ > THR) != 0ull) { \
            const float d_ = __builtin_fmaxf(mt_, 0.f), alpha_ = __builtin_amdgcn_exp2f(-d_); \
            mref += d_; lsum *= alpha_; \
            _Pragma("unroll") for (int r = 0; r < 16; ++r) { o0[r] *= alpha_; o1[r] *= alpha_; PN0[r] -= d_; PN1[r] -= d_; negm[r] = -mref; } \
        } \
        ABAR(); } while (0)
__device__ __forceinline__ void attn_unit(LAS unsigned char* lds, bf16_t* P, const float* qgain, const float* rope, int s, int h, int qb, int lane, int wid, bool dry) {
    const int r32 = lane & 31, hi = lane >> 5, kvh = h >> 2;
    const size_t rowbase = (size_t)s * SEQ;
    const bf16_t* ksrc = P + (rowbase + lane) * EVEN_IN + 1536 + kvh * 64 + wid * 8;
    const bf16_t* vsrc = P + (rowbase + 16 * (wid & 3) + (lane >> 2)) * EVEN_IN + 1664 + kvh * 64 + (wid >> 2) * 32 + (lane & 3) * 8;
    const int kdst = wid * 1024 + lane * 16;
    const int vdst = 16384 + (wid >> 2) * 4096 + (16 * (wid & 3) + (lane >> 2)) * 64 + (lane & 3) * 16;
    const size_t qrow = rowbase + (size_t)qb * 256 + wid * 32 + r32;
    const bf16_t* qg = P + qrow * EVEN_IN + 1024 + h * 64 + hi * 8;
    u32x4 krA = *(const u32x4*)ksrc, vrA = *(const u32x4*)vsrc;
    u32x4 krB = *(const u32x4*)(ksrc + (size_t)64 * EVEN_IN), vrB;
    bf16x8 qf[4];
    {
        float y[4][8]; float ssq = 0.f;
#pragma unroll
        for (int d0 = 0; d0 < 4; ++d0) { const u32x4 w = *(const u32x4*)(qg + d0 * 16);
            y[d0][0] = bflo(w.x); y[d0][1] = bfhi(w.x); y[d0][2] = bflo(w.y); y[d0][3] = bfhi(w.y); y[d0][4] = bflo(w.z); y[d0][5] = bfhi(w.z); y[d0][6] = bflo(w.w); y[d0][7] = bfhi(w.w);
#pragma unroll
            for (int e = 0; e < 8; ++e) ssq += y[d0][e] * y[d0][e]; }
        { const auto rr = __builtin_amdgcn_permlane32_swap(__float_as_uint(ssq), __float_as_uint(ssq), false, false); ssq = __uint_as_float(rr[0]) + __uint_as_float(rr[1]); }
        const float rh = __builtin_amdgcn_rsqf(ssq * (1.0f / 64.0f) + EPS) * C2;
        const int tq = qb * 256 + wid * 32 + r32;
#pragma unroll
        for (int d0 = 0; d0 < 4; ++d0) { const f32x4 g0 = *(const f32x4*)(qgain + d0 * 16 + hi * 8), g1 = *(const f32x4*)(qgain + d0 * 16 + hi * 8 + 4);
#pragma unroll
            for (int e = 0; e < 8; ++e) y[d0][e] *= rh * (e < 4 ? g0[e & 3] : g1[e & 3]); }
#pragma unroll
        for (int hf = 0; hf < 2; ++hf) {
            const int ir = hf ? (tq & 63) : (tq >> 6);
            const f32x4 c0 = *(const f32x4*)(rope + ir * 16 + 8 * hi), c1 = *(const f32x4*)(rope + ir * 16 + 8 * hi + 4);
            const f32x4 s0 = *(const f32x4*)(rope + 1024 + ir * 16 + 8 * hi), s1 = *(const f32x4*)(rope + 1024 + ir * 16 + 8 * hi + 4);
            u32x4 wa, wb; unsigned* pa = (unsigned*)&wa; unsigned* pb = (unsigned*)&wb; (void)pa; (void)pb;
            float oa[8], ob[8];
#pragma unroll
            for (int e = 0; e < 8; ++e) { const float c = (e < 4 ? c0[e & 3] : c1[e & 3]), sn = (e < 4 ? s0[e & 3] : s1[e & 3]); const float x1 = y[2 * hf][e], x2 = y[2 * hf + 1][e];
                oa[e] = x1 * c - x2 * sn; ob[e] = x2 * c + x1 * sn; }
            wa.x = cvt_pk_bf16(oa[0], oa[1]); wa.y = cvt_pk_bf16(oa[2], oa[3]); wa.z = cvt_pk_bf16(oa[4], oa[5]); wa.w = cvt_pk_bf16(oa[6], oa[7]);
            wb.x = cvt_pk_bf16(ob[0], ob[1]); wb.y = cvt_pk_bf16(ob[2], ob[3]); wb.z = cvt_pk_bf16(ob[4], ob[5]); wb.w = cvt_pk_bf16(ob[6], ob[7]);
            qf[2 * hf] = __builtin_bit_cast(bf16x8, wa); qf[2 * hf + 1] = __builtin_bit_cast(bf16x8, wb);
        }
    }
    *(LAS u32x4*)(lds + kdst) = krA; *(LAS u32x4*)(lds + vdst) = vrA; *(LAS u32x4*)(lds + 8192 + kdst) = krB;
    asm volatile("s_waitcnt vmcnt(0) lgkmcnt(0)\n\ts_barrier" ::: "memory");
    krA = *(const u32x4*)(ksrc + (size_t)2 * 64 * EVEN_IN); vrA = *(const u32x4*)(vsrc + (size_t)64 * EVEN_IN);
    const int koff = hi * 1024 + r32 * 16;
    const int voff = 16384 + ((lane >> 4) & 1) * 32 + (lane & 3) * 8 + (4 * hi + ((lane & 15) >> 2)) * 64;
    float mref, lsum = 0.f;
    f32x16 o0 = {}, o1 = {}, pA0 = {}, pA1 = {}, pB0, pB1;
    {
#pragma unroll
        for (int d0 = 0; d0 < 4; ++d0) {
            const bf16x8 k0 = *(const LAS bf16x8*)(lds + koff + d0 * 2048), k1 = *(const LAS bf16x8*)(lds + koff + d0 * 2048 + 512);
            pA0 = MFMA32(k0, qf[d0], pA0); pA1 = MFMA32(k1, qf[d0], pA1);
        }
        mref = rowmax32(pA0, pA1);
#pragma unroll
        for (int r = 0; r < 16; ++r) { pA0[r] -= mref; pA1[r] -= mref; }
    }
    f32x16 negm;
#pragma unroll
    for (int r = 0; r < 16; ++r) negm[r] = -mref;
    constexpr int NT = SEQ / 64;
    constexpr float THR = 8.0f;
    for (int t = 0; t < NT; t += 2) {
        ASTEP(t, pA0, pA1, pB0, pB1, krA, vrA, krB, vrB);
        ASTEP(t + 1, pB0, pB1, pA0, pA1, krB, vrB, krA, vrA);
    }
    lsum += __shfl_xor(lsum, 32);
    const float inv = 1.0f / lsum;
    bf16_t* op = P + qrow * EVEN_IN + 1792 + h * 64 + 4 * hi;
    u32x2 zq[8];
#pragma unroll
    for (int i = 0; i < 4; ++i) { zq[i] = *(const u32x2*)(op + 8 * i); zq[4 + i] = *(const u32x2*)(op + 32 + 8 * i); }
    if (!dry)
#pragma unroll
    for (int i = 0; i < 4; ++i) {
        { const u32x2 z = zq[i]; u32x2 w;
          w.x = cvt_pk_bf16(o0[4 * i] * inv * silu_f(bflo(z.x)), o0[4 * i + 1] * inv * silu_f(bfhi(z.x))); w.y = cvt_pk_bf16(o0[4 * i + 2] * inv * silu_f(bflo(z.y)), o0[4 * i + 3] * inv * silu_f(bfhi(z.y))); *(u32x2*)(op + 8 * i) = w; }
        { const u32x2 z = zq[4 + i]; u32x2 w;
          w.x = cvt_pk_bf16(o1[4 * i] * inv * silu_f(bflo(z.x)), o1[4 * i + 1] * inv * silu_f(bfhi(z.x))); w.y = cvt_pk_bf16(o1[4 * i + 2] * inv * silu_f(bflo(z.y)), o1[4 * i + 3] * inv * silu_f(bfhi(z.y))); *(u32x2*)(op + 32 + 8 * i) = w; }
    }
}

__device__ __forceinline__ void pool_loadU(u32x4 (&ur)[10], const bf16_t* P, int it, int tid) {
    const int t0 = (it & 63) * 64; const size_t rowbase = (size_t)(it >> 6) * SEQ;
#pragma unroll
    for (int i = 0; i < 10; ++i) {
        const int idx = tid + 512 * i, row = idx >> 6, ch = idx & 63, t = t0 - 8 + row;
        u32x4 v = {0u, 0u, 0u, 0u};
        if (t >= 0 && t < SEQ) v = *(const u32x4*)(P + (rowbase + t) * EVEN_IN + ch * 8);
        ur[i] = v;
    }
}
__device__ __forceinline__ void pool_run(LAS unsigned char* lds, bf16_t* P, const bf16_t* pwT, const float* pscale, int it0, int step, int tid, int lane, int wid, bool dry) {
    LAS unsigned char* U = lds; LAS unsigned char* DF = lds + 81920;
    u32x4 ur[10];
    if (it0 < 768) pool_loadU(ur, P, it0, tid);
    for (int it = it0; it < 768; it += step) {
    const int t0 = (it & 63) * 64; const size_t rowbase = (size_t)(it >> 6) * SEQ;
    u32x2 zz[8][2];
    { const int g = wid >> 1, th = wid & 1, fr = lane & 15, fq = lane >> 4;
#pragma unroll
      for (int db = 0; db < 8; ++db)
#pragma unroll
          for (int tb = 0; tb < 2; ++tb)
              zz[db][tb] = *(const u32x2*)(P + (rowbase + t0 + 32 * th + 16 * tb + fr) * EVEN_IN + 512 + g * 128 + 16 * db + 4 * fq); }
#pragma unroll
    for (int i = 0; i < 10; ++i) { const int idx = tid + 512 * i; *(LAS u32x4*)(U + (idx >> 6) * 1024 + (idx & 63) * 16) = ur[i]; }
    __syncthreads();
    if (it + step < 768) pool_loadU(ur, P, it + step, tid);
    bf16x8 af0[8];
    { const int g = wid >> 1, fr = lane & 15, fq = lane >> 4;
#pragma unroll
      for (int db = 0; db < 8; ++db) af0[db] = *(const bf16x8*)(pwT + ((size_t)(g * 128 + 16 * db + fr) * 128 + 8 * fq)); }
    {
        const int cp = tid & 255, half = tid >> 8, g = cp >> 6, w2 = 1 << g, tl0 = half * 32;
        const LAS unsigned* U32 = (const LAS unsigned*)U; LAS unsigned* D32 = (LAS unsigned*)DF;
        float sx = 0.f, sy = 0.f;
#pragma unroll
        for (int q = 0; q < 16; ++q) {
            if (q < 2 * w2) { const unsigned w = U32[(tl0 + 8 - w2 + q) * 256 + cp]; sx += bflo(w); sy += bfhi(w); }
        }
#pragma unroll 16
        for (int i = 0; i < 32; ++i) {
            const int tl = tl0 + i, t = t0 + tl;
            const int lo = (t - w2) < 0 ? 0 : (t - w2), hi2 = (t + w2) > SEQ ? SEQ : (t + w2);
            const float inv = 1.0f / (float)(hi2 - lo);
            const unsigned w = U32[(tl + 8) * 256 + cp];
            D32[tl * 260 + cp] = cvt_pk_bf16(sx * inv - bflo(w), sy * inv - bfhi(w));
            const unsigned wa = U32[(tl + 8 + w2) * 256 + cp], wb = U32[(tl + 8 - w2) * 256 + cp];
            sx += bflo(wa) - bflo(wb); sy += bfhi(wa) - bfhi(wb);
        }
    }
    __syncthreads();
    {
        const int g = wid >> 1, th = wid & 1, fr = lane & 15, fq = lane >> 4;
        f32x4 acc[8][2];
#pragma unroll
        for (int db = 0; db < 8; ++db) { acc[db][0] = (f32x4){0.f, 0.f, 0.f, 0.f}; acc[db][1] = (f32x4){0.f, 0.f, 0.f, 0.f}; }
#pragma unroll
        for (int ks = 0; ks < 4; ++ks) {
            const bf16x8 b0 = *(const LAS bf16x8*)(DF + (32 * th + fr) * 1040 + (g * 128 + 32 * ks + 8 * fq) * 2);
            const bf16x8 b1 = *(const LAS bf16x8*)(DF + (32 * th + 16 + fr) * 1040 + (g * 128 + 32 * ks + 8 * fq) * 2);
#pragma unroll
            for (int db = 0; db < 8; ++db) {
                const bf16x8 af = (ks == 0) ? af0[db] : *(const bf16x8*)(pwT + ((size_t)(g * 128 + 16 * db + fr) * 128 + 32 * ks + 8 * fq));
                acc[db][0] = MFMA16(af, b0, acc[db][0]); acc[db][1] = MFMA16(af, b1, acc[db][1]);
            }
        }
#pragma unroll
        for (int db = 0; db < 8; ++db) {
            const int col = g * 128 + 16 * db + 4 * fq;
            const f32x4 sc = *(const f32x4*)(pscale + col);
#pragma unroll
            for (int tb = 0; tb < 2; ++tb) {
                const int t = 32 * th + 16 * tb + fr;
                u32x2* pp = (u32x2*)(P + (rowbase + t0 + t) * EVEN_IN + 512 + col);
                const u32x2 z = zz[db][tb]; const f32x4 a = acc[db][tb] * sc; u32x2 w;
                w.x = cvt_pk_bf16(a[0] * silu_f(bflo(z.x)), a[1] * silu_f(bfhi(z.x))); w.y = cvt_pk_bf16(a[2] * silu_f(bflo(z.y)), a[3] * silu_f(bfhi(z.y))); if (!dry) *pp = w;
            }
        }
    }
    __syncthreads();
    }
}

__device__ __forceinline__ void sgu_item(LAS unsigned char* lds, bf16_t* P, const bf16_t* wsb, const float* bs, const float* sg, const float* ssv, int ch, int h, bool load_w, int tid, int lane, int wid, bool dry) {
    LAS unsigned char* GV = lds; LAS unsigned char* WT = lds + 36864; LAS unsigned char* GU = lds + 71680; LAS unsigned char* SZ = lds + 106496;
    const size_t row0 = (size_t)ch * 128;
#pragma unroll
    for (int i = 0; i < 4; ++i) {
        const int idx = tid + 512 * i, r = idx >> 4, c16 = idx & 15;
        const bf16_t* src = P + (row0 + r) * ODD_IN + h * 128 + c16 * 8;
        const u32x4 gu = *(const u32x4*)src, gv = *(const u32x4*)(src + 1024), sz = *(const u32x4*)(src + 2048);
        float part = ssv[(row0 + r) * 16 + c16];
        part += __shfl_xor(part, 1); part += __shfl_xor(part, 2); part += __shfl_xor(part, 4); part += __shfl_xor(part, 8);
        const float rv = __builtin_amdgcn_rsqf(part * (1.0f / 1024.0f) + EPS);
        const f32x4 g0 = *(const f32x4*)(sg + h * 128 + c16 * 8) * rv, g1 = *(const f32x4*)(sg + h * 128 + c16 * 8 + 4) * rv;
        u32x4 gn;
        gn.x = cvt_pk_bf16(bflo(gv.x) * g0[0], bfhi(gv.x) * g0[1]); gn.y = cvt_pk_bf16(bflo(gv.y) * g0[2], bfhi(gv.y) * g0[3]);
        gn.z = cvt_pk_bf16(bflo(gv.z) * g1[0], bfhi(gv.z) * g1[1]); gn.w = cvt_pk_bf16(bflo(gv.w) * g1[2], bfhi(gv.w) * g1[3]);
        *(LAS u32x4*)(GV + r * 288 + c16 * 16) = gn;
        *(LAS u32x4*)(GU + r * 272 + c16 * 16) = gu;
        *(LAS u32x4*)(SZ + r * 272 + c16 * 16) = sz;
        if (load_w) *(LAS u32x4*)(WT + r * 272 + c16 * 16) = *(const u32x4*)(wsb + ((size_t)(h * 128 + r) * 128 + c16 * 8));
    }
    __syncthreads();
    {
        const int fr = lane & 15, fq = lane >> 4;
        bf16x8 af[4];
#pragma unroll
        for (int ks = 0; ks < 4; ++ks) {
            const LAS unsigned char* ap = GV + (32 * ks + 8 * fq + (fr >> 2)) * 288 + (16 * wid + 4 * (fr & 3)) * 2;
            const s16x4 a0 = vtr(ap), a1 = vtr(ap + 4 * 288);
            af[ks] = (bf16x8){a0[0], a0[1], a0[2], a0[3], a1[0], a1[1], a1[2], a1[3]};
        }
        f32x4 acc[8];
#pragma unroll
        for (int pb = 0; pb < 8; ++pb) acc[pb] = (f32x4){0.f, 0.f, 0.f, 0.f};
#pragma unroll
        for (int ks = 0; ks < 4; ++ks)
#pragma unroll
            for (int pb = 0; pb < 8; ++pb) {
                const bf16x8 bfr = *(const LAS bf16x8*)(WT + (16 * pb + fr) * 272 + (32 * ks + 8 * fq) * 2);
                acc[pb] = MFMA16(af[ks], bfr, acc[pb]);
            }
#pragma unroll
        for (int pb = 0; pb < 8; ++pb) {
            const int p = 16 * pb + fr; const float bias = bs[h * 128 + p];
            LAS u32x2* gp = (LAS u32x2*)(GU + p * 272 + (16 * wid + 4 * fq) * 2);
            const u32x2 gu = *gp, sz = *(const LAS u32x2*)(SZ + p * 272 + (16 * wid + 4 * fq) * 2);
            u32x2 w;
            const f32x4 ug = gelu4((f32x4){bflo(gu.x), bfhi(gu.x), bflo(gu.y), bfhi(gu.y)});
            const f32x4 zs = silu4((f32x4){bflo(sz.x), bfhi(sz.x), bflo(sz.y), bfhi(sz.y)});
            w.x = cvt_pk_bf16(ug[0] * (acc[pb][0] + bias) * zs[0], ug[1] * (acc[pb][1] + bias) * zs[1]);
            w.y = cvt_pk_bf16(ug[2] * (acc[pb][2] + bias) * zs[2], ug[3] * (acc[pb][3] + bias) * zs[3]);
            *gp = w;
        }
    }
    __syncthreads();
#pragma unroll
    for (int i = 0; i < 4; ++i) {
        const int idx = tid + 512 * i, r = idx >> 4, c16 = idx & 15;
        if (!dry) *(u32x4*)(P + (row0 + r) * ODD_IN + h * 128 + c16 * 8) = *(const LAS u32x4*)(GU + r * 272 + c16 * 16);
    }
    __syncthreads();
}


__device__ __forceinline__ void sgu_load(u32x4 (&gu)[4], u32x4 (&gv)[4], u32x4 (&sz)[4], float (&part)[4], const bf16_t* P, const float* ssv, int ch, int h, int tid) {
    const size_t row0 = (size_t)ch * 128;
#pragma unroll
    for (int i = 0; i < 4; ++i) {
        const int idx = tid + 512 * i, r = idx >> 4, c16 = idx & 15;
        const bf16_t* src = P + (row0 + r) * ODD_IN + h * 128 + c16 * 8;
        gu[i] = *(const u32x4*)src; gv[i] = *(const u32x4*)(src + 1024); sz[i] = *(const u32x4*)(src + 2048);
        part[i] = ssv[(row0 + r) * 16 + c16];
    }
}
__device__ __forceinline__ void sgu_run(LAS unsigned char* lds, bf16_t* P, const bf16_t* wsb, const float* bs, const float* sg, const float* ssv, int ch0, int cstep, int h, int tid, int lane, int wid, bool dry) {
    LAS unsigned char* GV = lds; LAS unsigned char* WT = lds + 36864; LAS unsigned char* GU = lds + 71680; LAS unsigned char* SZ = lds + 106496;
    u32x4 gu[4], gv[4], sz[4]; float part[4];
    if (ch0 < 384) sgu_load(gu, gv, sz, part, P, ssv, ch0, h, tid);
    bool first = true;
    for (int ch = ch0; ch < 384; ch += cstep) {
        const size_t row0 = (size_t)ch * 128;
#pragma unroll
        for (int i = 0; i < 4; ++i) {
            const int idx = tid + 512 * i, r = idx >> 4, c16 = idx & 15;
            float pt = part[i];
            pt += __shfl_xor(pt, 1); pt += __shfl_xor(pt, 2); pt += __shfl_xor(pt, 4); pt += __shfl_xor(pt, 8);
            const float rv = __builtin_amdgcn_rsqf(pt * (1.0f / 1024.0f) + EPS);
            const f32x4 g0 = *(const f32x4*)(sg + h * 128 + c16 * 8) * rv, g1 = *(const f32x4*)(sg + h * 128 + c16 * 8 + 4) * rv;
            u32x4 gn;
            gn.x = cvt_pk_bf16(bflo(gv[i].x) * g0[0], bfhi(gv[i].x) * g0[1]); gn.y = cvt_pk_bf16(bflo(gv[i].y) * g0[2], bfhi(gv[i].y) * g0[3]);
            gn.z = cvt_pk_bf16(bflo(gv[i].z) * g1[0], bfhi(gv[i].z) * g1[1]); gn.w = cvt_pk_bf16(bflo(gv[i].w) * g1[2], bfhi(gv[i].w) * g1[3]);
            *(LAS u32x4*)(GV + r * 288 + c16 * 16) = gn;
            *(LAS u32x4*)(GU + r * 272 + c16 * 16) = gu[i];
            *(LAS u32x4*)(SZ + r * 272 + c16 * 16) = sz[i];
            if (first) *(LAS u32x4*)(WT + r * 272 + c16 * 16) = *(const u32x4*)(wsb + ((size_t)(h * 128 + r) * 128 + c16 * 8));
        }
        first = false;
        __syncthreads();
        if (ch + cstep < 384) sgu_load(gu, gv, sz, part, P, ssv, ch + cstep, h, tid);
        {
            const int fr = lane & 15, fq = lane >> 4;
            bf16x8 af[4];
#pragma unroll
            for (int ks = 0; ks < 4; ++ks) {
                const LAS unsigned char* ap = GV + (32 * ks + 8 * fq + (fr >> 2)) * 288 + (16 * wid + 4 * (fr & 3)) * 2;
                const s16x4 a0 = vtr(ap), a1 = vtr(ap + 4 * 288);
                af[ks] = (bf16x8){a0[0], a0[1], a0[2], a0[3], a1[0], a1[1], a1[2], a1[3]};
            }
            f32x4 acc[8];
#pragma unroll
            for (int pb = 0; pb < 8; ++pb) acc[pb] = (f32x4){0.f, 0.f, 0.f, 0.f};
#pragma unroll
            for (int ks = 0; ks < 4; ++ks)
#pragma unroll
                for (int pb = 0; pb < 8; ++pb) {
                    const bf16x8 bfr = *(const LAS bf16x8*)(WT + (16 * pb + fr) * 272 + (32 * ks + 8 * fq) * 2);
                    acc[pb] = MFMA16(af[ks], bfr, acc[pb]);
                }
#pragma unroll
            for (int pb = 0; pb < 8; ++pb) {
                const int p = 16 * pb + fr; const float bias = bs[h * 128 + p];
                LAS u32x2* gp = (LAS u32x2*)(GU + p * 272 + (16 * wid + 4 * fq) * 2);
                const u32x2 gu2 = *gp, sz2 = *(const LAS u32x2*)(SZ + p * 272 + (16 * wid + 4 * fq) * 2);
                u32x2 w;
                const f32x4 ug = gelu4((f32x4){bflo(gu2.x), bfhi(gu2.x), bflo(gu2.y), bfhi(gu2.y)});
                const f32x4 zs = silu4((f32x4){bflo(sz2.x), bfhi(sz2.x), bflo(sz2.y), bfhi(sz2.y)});
                w.x = cvt_pk_bf16(ug[0] * (acc[pb][0] + bias) * zs[0], ug[1] * (acc[pb][1] + bias) * zs[1]);
                w.y = cvt_pk_bf16(ug[2] * (acc[pb][2] + bias) * zs[2], ug[3] * (acc[pb][3] + bias) * zs[3]);
                *gp = w;
            }
        }
        __syncthreads();
#pragma unroll
        for (int i = 0; i < 4; ++i) {
            const int idx = tid + 512 * i, r = idx >> 4, c16 = idx & 15;
            if (!dry) *(u32x4*)(P + (row0 + r) * ODD_IN + h * 128 + c16 * 8) = *(const LAS u32x4*)(GU + r * 272 + c16 * 16);
        }
        __syncthreads();
    }
}

#define XB_TMO      128
#define XB_XCNT(j)  (256  + 64 * (j))
#define XB_XSUB(j)  (1280 + 64 * (j))
#define XB_XGEN(j)  (2304 + 64 * (j))
#define XB_TOP      3328
#define XB_TOPGEN   3392
#define XCD_BAR_WORDS 3456
#define XB_SPIN_CAP (1u << 18)

__device__ __forceinline__ unsigned xb_ld(unsigned* p)              { return __hip_atomic_load(p, __ATOMIC_RELAXED, __HIP_MEMORY_SCOPE_AGENT); }
__device__ __forceinline__ unsigned xb_add(unsigned* p, unsigned v) { return __hip_atomic_fetch_add(p, v, __ATOMIC_RELAXED, __HIP_MEMORY_SCOPE_AGENT); }
__device__ __forceinline__ unsigned xb_xcc_id() { return (unsigned)__builtin_amdgcn_s_getreg((3 << 11) | 20) & 0xFu; }
#define XB_SPIN(cond, bar) do { unsigned _sp = 0; while (cond) { __builtin_amdgcn_s_sleep(1); \
    if ((++_sp & 255u) == 0u) { if (xb_ld(&(bar)[XB_TMO])) break; if (_sp > XB_SPIN_CAP) { atomicAdd(&(bar)[XB_TMO], 1u); break; } } } } while (0)

struct XcdBarrier {
    unsigned* bar; unsigned x;
    volatile LAS unsigned* st;
};

__device__ __forceinline__ XcdBarrier xcd_barrier_post(unsigned* bar, volatile LAS unsigned* st) {
    XcdBarrier b; b.bar = bar; b.x = xb_xcc_id(); b.st = st;
    if (threadIdx.x == 0) st[2] = xb_add(&bar[XB_XCNT(b.x)], 1u) + 1u;
    return b;
}
__device__ __forceinline__ void xcd_barrier_complete(unsigned* bar, unsigned x, unsigned& nloc, unsigned& nx) {
    const unsigned G = gridDim.x * gridDim.y * gridDim.z;
    unsigned sum, cnt, mine, sp = 0u;
    for (;;) {
        sum = 0u; cnt = 0u; mine = 0u;
#pragma unroll
        for (unsigned j = 0; j < 16; ++j) { const unsigned c = xb_ld(&bar[XB_XCNT(j)]); sum += c; cnt += (c > 0u) ? 1u : 0u; mine = (j == x) ? c : mine; }
        if (sum == G) break;
        __builtin_amdgcn_s_sleep(1);
        if ((++sp & 255u) == 0u) { if (xb_ld(&bar[XB_TMO])) break; if (sp > XB_SPIN_CAP) { atomicAdd(&bar[XB_TMO], 1u); break; } }
    }
    nloc = mine > 0u ? mine : 1u; nx = cnt > 0u ? cnt : 1u;
}

__device__ __forceinline__ void xcd_barrier(const XcdBarrier& b) {
    asm volatile("s_waitcnt vmcnt(0)" ::: "memory");
    __syncthreads();
    if (threadIdx.x == 0) {
        unsigned* bar = b.bar;
        __builtin_amdgcn_s_waitcnt(0);
        unsigned nloc = b.st[0], nx = b.st[1];
        if (nloc == 0u) { xcd_barrier_complete(bar, b.x, nloc, nx); b.st[0] = nloc; b.st[1] = nx; }
        const unsigned old = xb_add(&bar[XB_XSUB(b.x)], 1u);
        const unsigned gen = old / nloc;
        if (old + 1u == (gen + 1u) * nloc) {
            __builtin_amdgcn_fence(__ATOMIC_RELEASE, "agent");
            asm volatile("s_waitcnt vmcnt(0)" ::: "memory");
            const unsigned og = xb_add(&bar[XB_TOP], 1u);
            const unsigned tg = og / nx;
            if (og + 1u == (tg + 1u) * nx) xb_add(&bar[XB_TOPGEN], 1u);
            else XB_SPIN(xb_ld(&bar[XB_TOPGEN]) == tg, bar);
            __builtin_amdgcn_fence(__ATOMIC_ACQUIRE, "agent");
            xb_add(&bar[XB_XGEN(b.x)], 1u);
            asm volatile("s_waitcnt vmcnt(0)" ::: "memory");
        } else {
            XB_SPIN(xb_ld(&bar[XB_XGEN(b.x)]) == gen, bar);
            __builtin_amdgcn_fence(__ATOMIC_ACQUIRE, "agent");
            asm volatile("s_waitcnt vmcnt(0)" ::: "memory");
        }
    }
    __syncthreads();
}

#ifdef DIAG
#define DG(k) (DIAG == (k))
#else
#define DG(k) true
#endif
__global__ void __launch_bounds__(512, 2) fwd_kernel(Args a) {
    extern __shared__ __attribute__((aligned(16))) unsigned char lds_raw[];
    LAS unsigned char* lds = (LAS unsigned char*)lds_raw;
    const int wid = __builtin_amdgcn_readfirstlane(threadIdx.x >> 6);
    const int G = gridDim.x, bx0 = blockIdx.x;
    int bx = bx0;
    unsigned char* ws = a.ws;
    bf16_t* P = (bf16_t*)(ws + WS_P); bf16_t* XB = (bf16_t*)(ws + WS_XB);
    float* SS = (float*)(ws + WS_SS); float* SSV = (float*)(ws + WS_SSV);
    const float* rope = (const float*)(ws + WS_ROPE);
    if (threadIdx.x < 4) ((LAS unsigned*)(lds + BARW_OFF))[threadIdx.x] = 0u;
    __syncthreads();
    XcdBarrier xbar = xcd_barrier_post((unsigned*)(ws + WS_BAR), (volatile LAS unsigned*)(lds + BARW_OFF));
    for (int ph = a.ph_lo; ph < a.ph_hi; ++ph) {
        if (ph > 0 && ((ph - 1) & 3) == 1 && (((ph - 1) >> 2) & 1)) continue;
#ifdef PROBE_KIND
        const int kind = (ph == 0) ? 0 : ((((ph - 1) & 3) == 2) ? ((((ph - 1) >> 2) & 1) ? 3 : 2) : 1);
        const int nrep = (kind == PROBE_KIND && a.ph_lo == 0) ? 2 : 1;
#else
        const int nrep = 1;
#endif
        for (int rep = 0; rep < nrep; ++rep) {
        const bool dry = (rep + 1 < nrep);
        if (rep) { __syncthreads(); cg::this_grid().sync(); }
        int tid = threadIdx.x; asm volatile("" : "+v"(tid));
        const int lane = tid & 63;
        if (ph == 0) {
            if (DG(0)) prologue(a, lds, tid, lane, wid);
            __syncthreads();
        } else {
            const int layer = (ph - 1) >> 2, sub4 = (ph - 1) & 3, j = layer >> 1; const bool even = (layer & 1) == 0;
            const int sub = (sub4 == 0) ? 0 : (sub4 == 1 ? 3 : sub4 - 1);
            if (sub == 3) {
                kprep_phase(P, a.in[7] + j * 64, rope, tid, bx, G);
            } else if (sub == 0) {
                if (even) {
                    pg8::Gemm g{XB, (const bf16_t*)(ws + WS_WINE) + (size_t)j * 2304 * 1024, MTOK, EVEN_IN, 1024, 1024, 0};
                    pg8::StaticOrder S; S.init(MTOK, EVEN_IN, G, bx);
                    pg8::EpiEvenIn E{P, SS, (LAS float*)(lds + RST_OFF)};
                    if (DG(1)) pg8::gemm_phase(lds, g, S, E, tid);
                } else {
                    pg8::Gemm g{XB, (const bf16_t*)(ws + WS_WINO) + (size_t)j * 3072 * 1024, MTOK, ODD_IN, 1024, 1024, 0};
                    pg8::StaticOrder S; S.init(MTOK, ODD_IN, G, bx);
                    pg8::EpiOddIn E{P, SS, SSV, (LAS float*)(lds + RST_OFF)};
                    if (DG(2)) pg8::gemm_phase(lds, g, S, E, tid);
                }
            } else if (sub == 1) {
                if (even) {
                    const int x = bx & 7, y = bx >> 3, gpx = G >> 3;
                    const bool xcdmap = (G % 8 == 0);
                    for (int i = 0;; ++i) {
                        const int v = xcdmap ? ((i * 8 + x) * gpx + y) : (i * G + bx);
                        if (v >= 1536) break;
                        const int grp = v >> 6, w = v & 63;
                        if (DG(3)) attn_unit(lds, P, a.in[6] + j * 64, rope, grp >> 1, (grp & 1) * 4 + (w >> 4), w & 15, lane, wid, dry);
                    }
                    const bf16_t* pwT = (const bf16_t*)(ws + WS_POOLW) + (size_t)j * 4 * 128 * 128;
                    if (DG(4)) pool_run(lds, P, pwT, a.in[5] + j * 512, bx, G, tid, lane, wid, dry);
                } else {
                    const bf16_t* wsb = (const bf16_t*)(ws + WS_WSB) + (size_t)j * 8 * 128 * 128;
                    int hprev = -1;
                    if (G % 8 == 0) {
                        const int h = bx & 7;
                        if (DG(5)) sgu_run(lds, P, wsb, a.in[13] + j * 1024, a.in[11] + j * 1024, SSV, bx >> 3, G >> 3, h, tid, lane, wid, dry);
                    } else {
                        for (int it = bx; it < 3072; it += G) { const int h = it & 7; if (DG(5)) sgu_item(lds, P, wsb, a.in[13] + j * 1024, a.in[11] + j * 1024, SSV, it >> 3, h, h != hprev, tid, lane, wid, dry); hprev = h; }
                    }
                }
            } else {
                if (even) {
                    pg8::Gemm g{P + 512, (const bf16_t*)(ws + WS_WOUTE) + (size_t)j * 1024 * 1024, MTOK, 1024, 1024, EVEN_IN, 1536};
                    pg8::StaticOrder S; S.init(MTOK, 1024, G, bx);
                    pg8::EpiOut E{a.out, layer == 0 ? a.in[0] : a.out, layer == 0 ? a.in[1] - (size_t)MPROMPT * DM : a.out, XB, SS, dry, layer == 3};
                    if (DG(6)) pg8::gemm_phase(lds, g, S, E, tid);
                } else {
                    pg8::Gemm g{P, (const bf16_t*)(ws + WS_WOUTO) + (size_t)j * 1024 * 1024, MTOK, 1024, 1024, ODD_IN, 0};
                    pg8::StaticOrder S; S.init(MTOK, 1024, G, bx);
                    pg8::EpiOut E{a.out, layer == 0 ? a.in[0] : a.out, layer == 0 ? a.in[1] - (size_t)MPROMPT * DM : a.out, XB, SS, dry, layer == 3};
                    if (DG(6)) pg8::gemm_phase(lds, g, S, E, tid);
                }
            }
        }
        }
        if (ph + 1 < a.ph_hi) { if (a.ph_hi > NPHASE) cg::this_grid().sync(); else xcd_barrier(xbar); }
        if (ph == a.ph_lo && ph + 1 < a.ph_hi) {
            volatile LAS unsigned* st = (volatile LAS unsigned*)(lds + BARW_OFF);
            if (threadIdx.x == 0) {
                unsigned* bar = (unsigned*)(ws + WS_BAR); bool ok = (G % 8 == 0) && (xbar.x < 8u);
                for (unsigned jx = 0; jx < 8; ++jx) ok = ok && (xb_ld(&bar[XB_XCNT(jx)]) == (unsigned)(G / 8));
                st[3] = ok ? 1u : 0u;
            }
            __syncthreads();
            if (st[3]) bx = __builtin_amdgcn_readfirstlane((int)xbar.x + 8 * (int)(st[2] - 1u));
        }
    }
}

extern "C" void kernel_launch(void* const* d_in, const int* in_sizes, int n_in, void* d_out, int out_size, void* d_ws, size_t ws_size, hipStream_t stream) {
    static int grid = 0;
    if (grid == 0) {
        if (n_in != 15 || out_size != MTOK * DM || ws_size < WS_END) { fprintf(stderr, "kernel_launch: unexpected shapes (n_in %d out %d ws %zu need %zu)\n", n_in, out_size, ws_size, (size_t)WS_END); grid = -1; return; }
        int dev = 0, cus = 0, per_cu = 0;
        (void)hipGetDevice(&dev);
        (void)hipDeviceGetAttribute(&cus, hipDeviceAttributeMultiprocessorCount, dev);
        if (hipFuncSetAttribute((const void*)fwd_kernel, hipFuncAttributeMaxDynamicSharedMemorySize, LDS_BYTES) != hipSuccess) { fprintf(stderr, "kernel_launch: hipFuncSetAttribute failed\n"); grid = -1; return; }
        if (hipOccupancyMaxActiveBlocksPerMultiprocessor(&per_cu, (const void*)fwd_kernel, 512, LDS_BYTES) != hipSuccess || per_cu < 1) { fprintf(stderr, "kernel_launch: occupancy query gave %d\n", per_cu); per_cu = 1; }
        (void)hipGetLastError();
        grid = cus * per_cu;
        if (grid <= 0) grid = 256;
    }
    if (grid < 0) return;
    (void)hipMemsetAsync((char*)d_ws + WS_BAR, 0, 16384, stream);
    Args a{};
    for (int i = 0; i < 15; ++i) a.in[i] = (const float*)d_in[i];
    a.out = (float*)d_out; a.ws = (unsigned char*)d_ws;
#if N_LAUNCH_MODE == 1
    a.ph_lo = 0; a.ph_hi = NPHASE;
    void* args[] = {&a};
    hipError_t e = hipLaunchCooperativeKernel((const void*)fwd_kernel, dim3(grid), dim3(512), args, LDS_BYTES, stream);
    if (e != hipSuccess) fprintf(stderr, "cooperative launch failed: %s (grid %d)\n", hipGetErrorString(e), grid);
#else
    for (int ph = 0; ph < NPHASE; ++ph) {
        a.ph_lo = ph; a.ph_hi = ph + 1;
        hipLaunchKernelGGL(fwd_kernel, dim3(grid), dim3(512), LDS_BYTES, stream, a);
    }
#endif
}
```

```cpp
#include <hip/hip_runtime.h>
#include <hip/hip_cooperative_groups.h>
#include <cstdio>
#include <cstdint>
namespace cg = cooperative_groups;

#define LAS __attribute__((address_space(3)))
typedef unsigned short bf16_t;
typedef short bf16x8 __attribute__((ext_vector_type(8)));
typedef short s16x4 __attribute__((ext_vector_type(4)));
typedef float f32x2 __attribute__((ext_vector_type(2)));
typedef float f32x4 __attribute__((ext_vector_type(4)));
typedef float f32x16 __attribute__((ext_vector_type(16)));
typedef unsigned u32x2 __attribute__((ext_vector_type(2)));
typedef unsigned u32x4 __attribute__((ext_vector_type(4)));

#ifndef N_LAUNCH_MODE
#define N_LAUNCH_MODE 1
#endif

constexpr int DM = 1024, SEQ = 4096, NSEQ = 12, MTOK = NSEQ * SEQ, MPROMPT = 8 * SEQ;
constexpr int EVEN_IN = 2304, ODD_IN = 3072;
constexpr float EPS = 1e-6f;
constexpr float C2 = 0.125f * 1.4426950408889634f;
constexpr int NPHASE = 17;

constexpr size_t WS_WINE = 0;
constexpr size_t WS_WOUTE = WS_WINE + 2ull * 2304 * 1024 * 2;
constexpr size_t WS_WINO = WS_WOUTE + 2ull * 1024 * 1024 * 2;
constexpr size_t WS_WOUTO = WS_WINO + 2ull * 3072 * 1024 * 2;
constexpr size_t WS_POOLW = WS_WOUTO + 2ull * 1024 * 1024 * 2;
constexpr size_t WS_WSB = WS_POOLW + 2ull * 4 * 128 * 128 * 2;
constexpr size_t WS_ROPE = WS_WSB + 2ull * 8 * 128 * 128 * 2;
constexpr size_t WS_BAR = WS_ROPE + 8192;
constexpr size_t WS_SS = 32ull << 20;
constexpr size_t WS_SSV = WS_SS + (size_t)MTOK * 16 * 4;
constexpr size_t WS_XB = 40ull << 20;
constexpr size_t WS_P = WS_XB + (size_t)MTOK * 1024 * 2;
constexpr size_t WS_END = WS_P + (size_t)MTOK * 3072 * 2;
static_assert(WS_BAR + 16384 <= WS_SS && WS_SSV + (size_t)MTOK * 64 <= WS_XB, "ws map");

constexpr int LDS_BYTES = 159760;
constexpr int BARW_OFF = 159744;
constexpr int XL_OFF = 131072;
constexpr int ROPE_OFF = 139264;
constexpr int RST_OFF = 147456;

__device__ __forceinline__ unsigned cvt_pk_bf16(float lo, float hi) { unsigned r; asm volatile("v_cvt_pk_bf16_f32 %0, %1, %2" : "=v"(r) : "v"(lo), "v"(hi)); return r; }
__device__ __forceinline__ float bflo(unsigned w) { return __uint_as_float(w << 16); }
__device__ __forceinline__ float bfhi(unsigned w) { return __uint_as_float(w & 0xffff0000u); }
__device__ __forceinline__ float silu_f(float v) { return v * __builtin_amdgcn_rcpf(1.f + __builtin_amdgcn_exp2f(-1.4426950408889634f * v)); }
__device__ __forceinline__ float wave_sum(float v) {
#pragma unroll
    for (int o = 1; o < 64; o <<= 1) v += __shfl_xor(v, o);
    return v;
}
#define LDS_WAIT() asm volatile("s_waitcnt lgkmcnt(0)" ::: "memory")
__device__ __forceinline__ f32x2 gelu_pk(f32x2 v) {
    const f32x2 av = __builtin_elementwise_abs(v), d = av * 0.2316418882f + 1.0f;
    f32x2 t; t.x = __builtin_amdgcn_rcpf(d.x); t.y = __builtin_amdgcn_rcpf(d.y);
    f32x2 q = t * 0.5307027145f + (-0.7265760135f); q = q * t + 0.7107068705f; q = q * t + (-0.142248368f); q = q * t + 0.127414796f; q = q * t;
    const f32x2 s = (v * v) * (-0.72134752044f);
    f32x2 e; e.x = __builtin_amdgcn_exp2f(s.x); e.y = __builtin_amdgcn_exp2f(s.y);
    const f32x2 m = v * (q * e), r = v - m;
    f32x2 o; o.x = v.x < 0.f ? m.x : r.x; o.y = v.y < 0.f ? m.y : r.y; return o;
}
__device__ __forceinline__ f32x4 gelu4(f32x4 v) { f32x2 a = gelu_pk((f32x2){v[0], v[1]}), b = gelu_pk((f32x2){v[2], v[3]}); return (f32x4){a.x, a.y, b.x, b.y}; }
__device__ __forceinline__ f32x4 silu4(f32x4 v) { return (f32x4){silu_f(v[0]), silu_f(v[1]), silu_f(v[2]), silu_f(v[3])}; }

__device__ __forceinline__ u32x4 pack8(f32x4 a, f32x4 b) { u32x4 w; w.x = cvt_pk_bf16(a[0], a[1]); w.y = cvt_pk_bf16(a[2], a[3]); w.z = cvt_pk_bf16(b[0], b[1]); w.w = cvt_pk_bf16(b[2], b[3]); return w; }
__device__ __forceinline__ float sq4(f32x4 a) { return (a[0] * a[0] + a[1] * a[1]) + (a[2] * a[2] + a[3] * a[3]); }
__device__ __forceinline__ float fq_sum(float s) {
    const auto a = __builtin_amdgcn_permlane16_swap(__float_as_uint(s), __float_as_uint(s), false, false);
    const float t = __uint_as_float(a[0]) + __uint_as_float(a[1]);
    const auto b = __builtin_amdgcn_permlane32_swap(__float_as_uint(t), __float_as_uint(t), false, false);
    return __uint_as_float(b[0]) + __uint_as_float(b[1]);
}
__device__ __forceinline__ float xor32(float v, bool lo) {
    const auto a = __builtin_amdgcn_permlane32_swap(__float_as_uint(v), __float_as_uint(v), false, false);
    return __uint_as_float(lo ? a[1] : a[0]);
}
__device__ __forceinline__ float row_rstd(const float* ss, int row, int fq) {
    const f32x4 p = *(const f32x4*)(ss + (size_t)row * 16 + 4 * fq);
    const float s = fq_sum((p[0] + p[1]) + (p[2] + p[3]));
    return __builtin_amdgcn_rsqf(s * (1.0f / 1024.0f) + EPS);
}

__device__ __forceinline__ void store_rows64(LAS unsigned char* st, bf16_t* base, size_t pitch, u32x4 val, int fr, int fq, int lane) {
    *(LAS u32x4*)(st + fr * 80 + fq * 16) = val;
    const u32x4 t = *(const LAS u32x4*)(st + (lane >> 2) * 80 + (lane & 3) * 16);
    *(u32x4*)(base + (size_t)(lane >> 2) * pitch + (lane & 3) * 8) = t;
}
namespace pg8 {
constexpr int BM = 256, BK = 64, HALF = 128, HTB = HALF * BK * 2, STAGE_BYTES = 8 * HTB, NXCD = 8, WGM = 8;
__host__ __device__ __forceinline__ int lds_byte(int r, int c) { const int st = (r >> 4) * 2 + (c >> 5), rr = r & 15, cc = c & 31, ob = rr * 64 + cc * 2; return st * 1024 + (ob ^ (((ob >> 9) & 1) << 5)); }
__host__ __device__ __forceinline__ void stage_rc(int b, int& R, int& C) { const int st = b / 1024, sb = b % 1024, swz = sb ^ (((sb >> 9) & 1) << 5); R = (st >> 1) * 16 + swz / 64; C = (st & 1) * 32 + (swz % 64) / 2; }
__host__ __device__ __forceinline__ int perm32(int rho) { const int n = rho >> 4, i = rho & 15; return 8 * (i >> 2) + 4 * n + (i & 3); }

struct Unit { int pm, pn; };
struct Gemm { const bf16_t* A; const bf16_t* Bt; int M, N, K, lda, xtra; };

struct StaticOrder {
    int nM, nN, nwg, G, c;
    __host__ __device__ void init(int M, int N, int G_, int c_) { nM = M / BM; nN = N / BM; nwg = nM * nN; G = G_; c = c_; }
    __host__ __device__ bool next(int i, Unit& u) const {
        const long L = (long)i * G + c; if (L >= nwg) return false;
        int wgid = (int)L; { const int q = nwg / NXCD, r = nwg % NXCD, xcd = wgid % NXCD, off = wgid / NXCD; wgid = (xcd < r ? xcd * (q + 1) : r * (q + 1) + (xcd - r) * q) + off; }
        const int nig = WGM * nN, gid = wgid / nig, fm = gid * WGM, gsz = (nM - fm) < WGM ? (nM - fm) : WGM;
        u.pm = fm + ((wgid % nig) % gsz); u.pn = (wgid % nig) / gsz; return true;
    }
};

template <class Epi>
__device__ __forceinline__ void gemm_phase(LAS unsigned char* lds, const Gemm g, const StaticOrder& S, const Epi& E, const int tid) {
    const int wid = __builtin_amdgcn_readfirstlane(tid >> 6), lane = tid & 63, wr = wid >> 2, wc = wid & 3, fr = lane & 15, fq = lane >> 4;
    const int K = g.K, nt = K / BK, lda = g.lda;
    unsigned voffA[2], voffB[2];
#pragma unroll
    for (int i = 0; i < 2; ++i) { int R, C; stage_rc(tid * 16 + i * 8192, R, C); const int Rb = (R & ~31) + perm32(R & 31);
        voffA[i] = (unsigned)(R * lda + C) * 2u; voffB[i] = (unsigned)(Rb * K + C) * 2u; }
    const size_t kstep = (size_t)(BK * 2);
    const size_t hstepA = (size_t)HALF * lda * 2, tstepA = 2 * hstepA;
    const size_t hstepB = (size_t)HALF * K * 2, tstepB = 2 * hstepB;
    const size_t xtra = (size_t)g.xtra;
    const unsigned ldsw = (unsigned)wid * 1024u;
    const int aoff = lds_byte(wr * 64 + fr, fq * 8), boff = lds_byte(wc * 32 + fr, fq * 8);
#define PG8_SA(b, h) (((b) * 2 + (h)) * HTB)
#define PG8_SB(b, h) ((4 + (b) * 2 + (h)) * HTB)
#define PG8_STAGE(bufoff, gbase, voff) do { _Pragma("unroll") for (int _i = 0; _i < 2; ++_i) \
        __builtin_amdgcn_global_load_lds((const unsigned*)((const char*)(gbase) + (voff)[_i]), (LAS unsigned*)(lds + (bufoff) + ldsw + _i * 8192), 16, 0, 0); } while (0)
#define PG8_LDA(dst, b, h) do { _Pragma("unroll") for (int m = 0; m < 4; ++m) _Pragma("unroll") for (int k = 0; k < 2; ++k) dst[m][k] = *(const LAS bf16x8*)(lds + PG8_SA(b, h) + aoff + m * 2048 + k * 1024); } while (0)
#define PG8_LDB(dst, b, h) do { _Pragma("unroll") for (int n = 0; n < 2; ++n) _Pragma("unroll") for (int k = 0; k < 2; ++k) dst[n][k] = *(const LAS bf16x8*)(lds + PG8_SB(b, h) + boff + n * 2048 + k * 1024); } while (0)
#define PG8_MMA(ai, bj, At, Bt) do { __builtin_amdgcn_s_setprio(1); _Pragma("unroll") for (int m = 0; m < 4; ++m) _Pragma("unroll") for (int n = 0; n < 2; ++n) _Pragma("unroll") for (int k = 0; k < 2; ++k) \
        acc[ai][bj][m][n] = __builtin_amdgcn_mfma_f32_16x16x32_bf16(Bt[n][k], At[m][k], acc[ai][bj][m][n], 0, 0, 0); __builtin_amdgcn_s_setprio(0); } while (0)
#define PG8_WAIT_V(n) asm volatile("s_waitcnt vmcnt(" #n ")" ::: "memory")
#define PG8_WAIT_L(n) asm volatile("s_waitcnt lgkmcnt(" #n ")" ::: "memory")
#define PG8_BAR __builtin_amdgcn_s_barrier()
#define PG8_SCHED __builtin_amdgcn_sched_barrier(0)
    Unit cur, nxt; int ui = 0;
    if (!S.next(0, cur)) return;
    f32x4 acc[2][2][4][2];
#pragma unroll
    for (int a = 0; a < 2; ++a)
#pragma unroll
        for (int b = 0; b < 2; ++b)
#pragma unroll
            for (int m = 0; m < 4; ++m)
#pragma unroll
                for (int n = 0; n < 2; ++n) acc[a][b][m][n] = (f32x4){0.f, 0.f, 0.f, 0.f};
    bf16x8 At[4][2], B0[2][2], B1[2][2];
    const char* cA = (const char*)g.A + (size_t)cur.pm * tstepA; const char* cB = (const char*)g.Bt + (size_t)cur.pn * tstepB;
    f32x4 pf[2];
    E.pre(cur.pm, tid, pf); E.post(0, tid, pf);
    PG8_STAGE(PG8_SB(0, 0), cB, voffB); PG8_STAGE(PG8_SB(0, 1), cB + hstepB, voffB); PG8_STAGE(PG8_SA(0, 0), cA, voffA); PG8_STAGE(PG8_SA(0, 1), cA + hstepA, voffA);
    if (wr == 1) PG8_BAR;
    PG8_WAIT_V(2); PG8_BAR;
    PG8_STAGE(PG8_SB(1, 0), cB + kstep, voffB); PG8_STAGE(PG8_SA(1, 0), cA + kstep, voffA); PG8_STAGE(PG8_SB(1, 1), cB + hstepB + kstep, voffB);
    PG8_WAIT_V(6); PG8_BAR;
    for (;;) {
        const bool has_next = S.next(ui + 1, nxt);
        const char* nA = has_next ? (const char*)g.A + (size_t)nxt.pm * tstepA : cA; const char* nB = has_next ? (const char*)g.Bt + (size_t)nxt.pn * tstepB : cB;
        for (int t = 0; t < nt; t += 2) {
            const bool last = (t == nt - 2);
            const char* a1 = cA + (size_t)(t + 1) * kstep + ((t + 1) >= 8 ? xtra : 0);
            const char* a2 = last ? nA : cA + (size_t)(t + 2) * kstep + ((t + 2) >= 8 ? xtra : 0); const char* b2 = last ? nB : cB + (size_t)(t + 2) * kstep;
            const char* a3 = a2 + kstep; const char* b3 = b2 + kstep;
            PG8_LDB(B0, 0, 0); PG8_LDB(B1, 0, 1); PG8_SCHED; PG8_LDA(At, 0, 0); PG8_STAGE(PG8_SA(1, 1), a1 + hstepA, voffA);
            PG8_WAIT_V(8); PG8_WAIT_L(0); PG8_BAR; PG8_MMA(0, 0, At, B0); PG8_MMA(0, 1, At, B1); PG8_BAR; PG8_SCHED;
            PG8_LDA(At, 0, 1); PG8_STAGE(PG8_SB(0, 0), b2, voffB); PG8_STAGE(PG8_SB(0, 1), b2 + hstepB, voffB); PG8_STAGE(PG8_SA(0, 0), a2, voffA);
            PG8_WAIT_V(8); PG8_WAIT_L(0); PG8_BAR; PG8_MMA(1, 0, At, B0); PG8_MMA(1, 1, At, B1); PG8_BAR; PG8_SCHED;
            PG8_LDB(B0, 1, 0); PG8_LDB(B1, 1, 1); PG8_SCHED; PG8_LDA(At, 1, 0); PG8_STAGE(PG8_SA(0, 1), a2 + hstepA, voffA);
            PG8_WAIT_V(8); PG8_WAIT_L(0); PG8_BAR; PG8_MMA(0, 0, At, B0); PG8_MMA(0, 1, At, B1); PG8_BAR; PG8_SCHED;
            PG8_LDA(At, 1, 1); PG8_STAGE(PG8_SB(1, 0), b3, voffB); PG8_STAGE(PG8_SB(1, 1), b3 + hstepB, voffB); PG8_STAGE(PG8_SA(1, 0), a3, voffA);
            PG8_WAIT_V(8); PG8_WAIT_L(0); PG8_BAR; PG8_MMA(1, 0, At, B0); PG8_MMA(1, 1, At, B1); PG8_BAR; PG8_SCHED;
        }
        if (wr == 0) PG8_BAR;
        if (has_next) E.pre(nxt.pm, tid, pf);
        E(acc, cur, wr, wc, fr, fq, ui & 1);
        if (has_next) E.post((ui + 1) & 1, tid, pf);
        if (!has_next) break;
#pragma unroll
        for (int a = 0; a < 2; ++a)
#pragma unroll
            for (int b = 0; b < 2; ++b)
#pragma unroll
                for (int m = 0; m < 4; ++m)
#pragma unroll
                    for (int n = 0; n < 2; ++n) acc[a][b][m][n] = (f32x4){0.f, 0.f, 0.f, 0.f};
        cur = nxt; cA = nA; cB = nB; ++ui;
        if (wr == 1) PG8_BAR;
    }
    PG8_WAIT_V(0);
    PG8_BAR;
#undef PG8_SA
#undef PG8_SB
#undef PG8_STAGE
#undef PG8_LDA
#undef PG8_LDB
#undef PG8_MMA
#undef PG8_WAIT_V
#undef PG8_WAIT_L
#undef PG8_BAR
#undef PG8_SCHED
}

struct EpiEvenIn {
    bf16_t* P; const float* ss; LAS float* rst;
    __device__ __forceinline__ void pre(int pm, int tid, f32x4 (&r)[2]) const {
        const float* p = ss + ((size_t)pm * BM + (tid >> 1)) * 16 + 8 * (tid & 1);
        r[0] = *(const f32x4*)p; r[1] = *(const f32x4*)(p + 4);
    }
    __device__ __forceinline__ void post(int slot, int tid, const f32x4 (&r)[2]) const {
        const f32x4 t = r[0] + r[1]; float s = (t[0] + t[1]) + (t[2] + t[3]);
        s += __shfl_xor(s, 1);
        if ((tid & 1) == 0) rst[slot * 256 + (tid >> 1)] = __builtin_amdgcn_rsqf(s * (1.0f / 1024.0f) + EPS);
    }
    __device__ __forceinline__ void operator()(const f32x4 (&acc)[2][2][4][2], const Unit& u, int wr, int wc, int fr_, int fq_, int slot) const {
        int fr = fr_, fq = fq_; asm volatile("" : "+v"(fr), "+v"(fq));
        const int pn = u.pn;
        const int col0 = pn * BM + wc * 32 + 8 * fq;
        float rs[2][4];
#pragma unroll
        for (int ai = 0; ai < 2; ++ai)
#pragma unroll
            for (int m = 0; m < 4; ++m) rs[ai][m] = rst[slot * 256 + ai * HALF + wr * 64 + m * 16 + fr];
#pragma unroll
        for (int ai = 0; ai < 2; ++ai)
#pragma unroll
            for (int m = 0; m < 4; ++m) {
                bf16_t* rowp = P + (size_t)(u.pm * BM + ai * HALF + wr * 64 + m * 16 + fr) * EVEN_IN + col0;
#pragma unroll
                for (int bj = 0; bj < 2; ++bj) {
                    f32x4 v0 = acc[ai][bj][m][0] * rs[ai][m], v1 = acc[ai][bj][m][1] * rs[ai][m];
                    *(u32x4*)(rowp + bj * HALF) = pack8(v0, v1);
                }
                asm volatile("" ::: "memory");
            }
    }
};

struct EpiOddIn {
    bf16_t* P; const float* ss; float* ssv; LAS float* rst;
    __device__ __forceinline__ void pre(int pm, int tid, f32x4 (&r)[2]) const {
        const float* p = ss + ((size_t)pm * BM + (tid >> 1)) * 16 + 8 * (tid & 1);
        r[0] = *(const f32x4*)p; r[1] = *(const f32x4*)(p + 4);
    }
    __device__ __forceinline__ void post(int slot, int tid, const f32x4 (&r)[2]) const {
        const f32x4 t = r[0] + r[1]; float s = (t[0] + t[1]) + (t[2] + t[3]);
        s += __shfl_xor(s, 1);
        if ((tid & 1) == 0) rst[slot * 256 + (tid >> 1)] = __builtin_amdgcn_rsqf(s * (1.0f / 1024.0f) + EPS);
    }
    __device__ __forceinline__ void operator()(const f32x4 (&acc)[2][2][4][2], const Unit& u, int wr, int wc, int fr_, int fq_, int slot) const {
        int fr = fr_, fq = fq_; asm volatile("" : "+v"(fr), "+v"(fq));
        const int pn = u.pn, col0 = pn * BM + wc * 32 + 8 * fq;
        float rs[2][4];
#pragma unroll
        for (int ai = 0; ai < 2; ++ai)
#pragma unroll
            for (int m = 0; m < 4; ++m) rs[ai][m] = rst[slot * 256 + ai * HALF + wr * 64 + m * 16 + fr];
#pragma unroll
        for (int ai = 0; ai < 2; ++ai)
#pragma unroll
            for (int m = 0; m < 4; ++m) {
                const int row = u.pm * BM + ai * HALF + wr * 64 + m * 16 + fr;
                const float r = rs[ai][m];
                bf16_t* rowp = P + (size_t)row * ODD_IN + col0;
                float sq = 0.f;
#pragma unroll
                for (int bj = 0; bj < 2; ++bj) {
                    f32x4 v0 = acc[ai][bj][m][0] * r, v1 = acc[ai][bj][m][1] * r;
                    if (pn >= 4 && pn < 8) { v0 = gelu4(v0); v1 = gelu4(v1); sq += sq4(v0) + sq4(v1); }
                    *(u32x4*)(rowp + bj * HALF) = pack8(v0, v1);
                }
                if (pn >= 4 && pn < 8) { sq = fq_sum(sq); if (fq == 0) ssv[(size_t)row * 16 + (pn - 4) * 4 + wc] = sq; }
                asm volatile("" ::: "memory");
            }
    }
};

struct EpiOut {
    float* X; const float* R0; const float* R1; bf16_t* XB; float* ss; bool dry; bool lastl;
    __device__ __forceinline__ void pre(int, int, f32x4 (&)[2]) const {}
    __device__ __forceinline__ void post(int, int, const f32x4 (&)[2]) const {}
    __device__ __forceinline__ void load2(f32x4 (&xv)[2][2][2], const float* rb, int b) const {
#pragma unroll
        for (int mm = 0; mm < 2; ++mm) {
            const float* xp = rb + (size_t)((b >> 1) * HALF + (2 * (b & 1) + mm) * 16) * DM;
#pragma unroll
            for (int bj = 0; bj < 2; ++bj) { xv[mm][bj][0] = *(const f32x4*)(xp + bj * HALF); xv[mm][bj][1] = *(const f32x4*)(xp + bj * HALF + 4); }
        }
    }
    __device__ __forceinline__ void operator()(const f32x4 (&acc)[2][2][4][2], const Unit& u, int wr, int wc, int fr_, int fq_, int slot) const {
        int fr = fr_, fq = fq_; asm volatile("" : "+v"(fr), "+v"(fq));
        const int pn = u.pn, col0 = pn * BM + wc * 32 + 8 * fq;
        const float* rb = ((u.pm * BM < MPROMPT) ? R0 : R1) + (size_t)(u.pm * BM + wr * 64 + fr) * DM + col0;
        f32x4 xa[2][2][2], xb2[2][2][2];
        load2(xa, rb, 0);
#pragma unroll
        for (int b = 0; b < 4; ++b) {
            if (b + 1 < 4) { if (b & 1) load2(xa, rb, b + 1); else load2(xb2, rb, b + 1); }
            const int ai = b >> 1;
#pragma unroll
            for (int mm = 0; mm < 2; ++mm) {
                const int m = 2 * (b & 1) + mm;
                const int row = u.pm * BM + ai * HALF + wr * 64 + m * 16 + fr;
                float* xp = X + (size_t)row * DM + col0; bf16_t* bp = XB + (size_t)row * DM + col0;
                float sq = 0.f;
#pragma unroll
                for (int bj = 0; bj < 2; ++bj) {
                    const f32x4 x0 = ((b & 1) ? xb2[mm][bj][0] : xa[mm][bj][0]) + acc[ai][bj][m][0], x1 = ((b & 1) ? xb2[mm][bj][1] : xa[mm][bj][1]) + acc[ai][bj][m][1];
                    if (!dry) { *(f32x4*)(xp + bj * HALF) = x0; *(f32x4*)(xp + bj * HALF + 4) = x1;
                    if (!lastl) *(u32x4*)(bp + bj * HALF) = pack8(x0, x1); }
                    sq += sq4(x0) + sq4(x1);
                }
                if (!lastl) { sq = fq_sum(sq); if (fq == 0 && !dry) ss[(size_t)row * 16 + pn * 4 + wc] = sq; }
            }
        }
    }
};
}

__device__ __forceinline__ void p0_transpose_item(const float* W, int K, int N, bf16_t* WT, const float* gk, LAS float* scr, int item, int lane) {
    const int nblk = N / 32, kb = item / nblk, nb = item % nblk, k0 = 64 * kb, n0 = 32 * nb;
#pragma unroll
    for (int i = 0; i < 8; ++i) {
        const int kk = 8 * i + (lane >> 3); f32x4 v = *(const f32x4*)(W + (size_t)(k0 + kk) * N + n0 + 4 * (lane & 7));
        if (gk) v = v * gk[k0 + kk];
        LAS float* d = scr + kk * 33 + 4 * (lane & 7); d[0] = v[0]; d[1] = v[1]; d[2] = v[2]; d[3] = v[3];
    }
    LDS_WAIT(); asm volatile("" ::: "memory");
    const int c = lane & 7;
#pragma unroll
    for (int j = 0; j < 4; ++j) { const int n = (lane >> 3) + 8 * j; const LAS float* s = scr + (8 * c) * 33 + n;
        u32x4 o; o.x = cvt_pk_bf16(s[0 * 33], s[1 * 33]); o.y = cvt_pk_bf16(s[2 * 33], s[3 * 33]); o.z = cvt_pk_bf16(s[4 * 33], s[5 * 33]); o.w = cvt_pk_bf16(s[6 * 33], s[7 * 33]);
        *(u32x4*)(WT + (size_t)(n0 + n) * K + k0 + 8 * c) = o; }
    LDS_WAIT(); asm volatile("" ::: "memory");
}

struct Args { const float* in[15]; float* out; unsigned char* ws; int ph_lo, ph_hi; };

__device__ __forceinline__ void prologue(const Args& a, LAS unsigned char* lds, int tid, int lane, int wid) {
    unsigned char* ws = a.ws;
    const int G = gridDim.x, gw = blockIdx.x * 8 + wid, NGW = G * 8;
    LAS float* scr = (LAS float*)(lds + wid * 16384);
    constexpr int I_INE = 16 * 72, I_OUT = 16 * 32, I_INO = 16 * 96, I_POOL = 2 * 4;
    constexpr int NITEMS = 2 * (I_INE + I_OUT + I_INO + I_OUT) + 8 * I_POOL;
    for (int it = gw; it < NITEMS; it += NGW) {
        int r = it;
        if (r < 2 * I_INE) { const int j = r / I_INE; p0_transpose_item(a.in[3] + (size_t)j * 1024 * 2304, 1024, 2304, (bf16_t*)(ws + WS_WINE) + (size_t)j * 2304 * 1024, a.in[2] + j * 1024, scr, r % I_INE, lane); continue; } r -= 2 * I_INE;
        if (r < 2 * I_OUT) { const int j = r / I_OUT; p0_transpose_item(a.in[8] + (size_t)j * 1024 * 1024, 1024, 1024, (bf16_t*)(ws + WS_WOUTE) + (size_t)j * 1024 * 1024, nullptr, scr, r % I_OUT, lane); continue; } r -= 2 * I_OUT;
        if (r < 2 * I_INO) { const int j = r / I_INO; p0_transpose_item(a.in[10] + (size_t)j * 1024 * 3072, 1024, 3072, (bf16_t*)(ws + WS_WINO) + (size_t)j * 3072 * 1024, a.in[9] + j * 1024, scr, r % I_INO, lane); continue; } r -= 2 * I_INO;
        if (r < 2 * I_OUT) { const int j = r / I_OUT; p0_transpose_item(a.in[14] + (size_t)j * 1024 * 1024, 1024, 1024, (bf16_t*)(ws + WS_WOUTO) + (size_t)j * 1024 * 1024, nullptr, scr, r % I_OUT, lane); continue; } r -= 2 * I_OUT;
        { const int mt = r / I_POOL; p0_transpose_item(a.in[4] + (size_t)mt * 128 * 128, 128, 128, (bf16_t*)(ws + WS_POOLW) + (size_t)mt * 128 * 128, nullptr, scr, r % I_POOL, lane); }
    }
    { const float* wsf = a.in[12]; bf16_t* dst = (bf16_t*)(ws + WS_WSB);
      for (int i = (blockIdx.x * 512 + tid) * 4; i < 2 * 8 * 128 * 128; i += G * 512 * 4) { const f32x4 v = *(const f32x4*)(wsf + i); u32x2 o; o.x = cvt_pk_bf16(v[0], v[1]); o.y = cvt_pk_bf16(v[2], v[3]); *(u32x2*)(dst + i) = o; } }
    { float* rope = (float*)(ws + WS_ROPE);
      for (int i = blockIdx.x * 512 + tid; i < 1024; i += G * 512) { const int idx = i >> 4, f = i & 15; const float inv = 1.0f / powf(10000.0f, (float)f / 16.0f); const float ang = (float)idx * inv; rope[i] = cosf(ang); rope[1024 + i] = sinf(ang); } }
    { const float* xp = a.in[0]; const float* xs = a.in[1]; float* ss = (float*)(ws + WS_SS); bf16_t* xb = (bf16_t*)(ws + WS_XB);
      for (int m = gw; m < MTOK; m += NGW) {
          const float* src = (m < MPROMPT) ? xp + (size_t)m * DM : xs + (size_t)(m - MPROMPT) * DM;
          f32x4 v[4]; float s = 0.f;
#pragma unroll
          for (int j = 0; j < 4; ++j) { v[j] = *(const f32x4*)(src + (lane + 64 * j) * 4); s += sq4(v[j]); }
          s = wave_sum(s);
#pragma unroll
          for (int j = 0; j < 4; ++j) { u32x2 o; o.x = cvt_pk_bf16(v[j][0], v[j][1]); o.y = cvt_pk_bf16(v[j][2], v[j][3]); *(u32x2*)(xb + (size_t)m * DM + (lane + 64 * j) * 4) = o; }
          if (lane < 16) ss[(size_t)m * 16 + lane] = (lane == 0) ? s : 0.f;
      } }
}

__device__ __forceinline__ void kprep_item(bf16_t* P, const float* kg, const float* rope, int idx, const u32x4 w) {
    const int e8 = idx & 7, hk = (idx >> 3) & 1, row = idx >> 4;
    float x[8] = {bflo(w.x), bfhi(w.x), bflo(w.y), bfhi(w.y), bflo(w.z), bfhi(w.z), bflo(w.w), bfhi(w.w)};
    float ssq = 0.f;
#pragma unroll
    for (int e = 0; e < 8; ++e) ssq += x[e] * x[e];
    ssq += __shfl_xor(ssq, 1); ssq += __shfl_xor(ssq, 2); ssq += __shfl_xor(ssq, 4);
    const float rh = __builtin_amdgcn_rsqf(ssq * (1.0f / 64.0f) + EPS);
    const int t = row & (SEQ - 1), ir = (e8 < 4) ? (t >> 6) : (t & 63), f0 = 8 * (e8 & 1);
    const f32x4 g0 = *(const f32x4*)(kg + e8 * 8), g1 = *(const f32x4*)(kg + e8 * 8 + 4);
    const f32x4 c0 = *(const f32x4*)(rope + ir * 16 + f0), c1 = *(const f32x4*)(rope + ir * 16 + f0 + 4);
    const f32x4 s0 = *(const f32x4*)(rope + 1024 + ir * 16 + f0), s1 = *(const f32x4*)(rope + 1024 + ir * 16 + f0 + 4);
    const float sgn = (e8 & 2) ? 1.0f : -1.0f;
    float o[8];
#pragma unroll
    for (int e = 0; e < 8; ++e) {
        const float y = x[e] * rh * (e < 4 ? g0[e & 3] : g1[e & 3]);
        const float other = __shfl_xor(y, 2);
        o[e] = y * (e < 4 ? c0[e & 3] : c1[e & 3]) + sgn * other * (e < 4 ? s0[e & 3] : s1[e & 3]);
    }
    u32x4 r; r.x = cvt_pk_bf16(o[0], o[1]); r.y = cvt_pk_bf16(o[2], o[3]); r.z = cvt_pk_bf16(o[4], o[5]); r.w = cvt_pk_bf16(o[6], o[7]);
    *(u32x4*)(P + (size_t)row * EVEN_IN + 1536 + hk * 64 + e8 * 8) = r;
}
__device__ __forceinline__ void kprep_phase(bf16_t* P, const float* kg, const float* rope, int tid, int bx, int G) {
    const int stride = G * 512;
    for (int base = bx * 512 + tid; base < MTOK * 16; base += 3 * stride) {
        u32x4 w[3];
#pragma unroll
        for (int q = 0; q < 3; ++q) { const int idx = base + q * stride; if (idx < MTOK * 16) w[q] = *(const u32x4*)(P + (size_t)(idx >> 4) * EVEN_IN + 1536 + ((idx >> 3) & 1) * 64 + (idx & 7) * 8); }
#pragma unroll
        for (int q = 0; q < 3; ++q) { const int idx = base + q * stride; if (idx < MTOK * 16) kprep_item(P, kg, rope, idx, w[q]); }
    }
}

#define MFMA32(a, b, c) __builtin_amdgcn_mfma_f32_32x32x16_bf16(a, b, c, 0, 0, 0)
#define MFMA16(a, b, c) __builtin_amdgcn_mfma_f32_16x16x32_bf16(a, b, c, 0, 0, 0)
__device__ __forceinline__ s16x4 vtr(const LAS unsigned char* p) { return __builtin_bit_cast(s16x4, __builtin_amdgcn_ds_read_tr16_b64_v4i16((LAS s16x4*)p)); }
__device__ __forceinline__ float max3f(float a, float b, float c) { return __builtin_fmaxf(__builtin_fmaxf(a, b), c); }

#define ABAR() asm volatile("s_waitcnt lgkmcnt(0)\n\ts_barrier" ::: "memory")
#define SGB(mask, n) __builtin_amdgcn_sched_group_barrier(mask, n, 0)
typedef __bf16 bf16v2 __attribute__((ext_vector_type(2)));
__device__ __forceinline__ unsigned cvtpk(float a, float b) { const bf16v2 r = __builtin_convertvector((f32x2){a, b}, bf16v2); return __builtin_bit_cast(unsigned, r); }
__device__ __forceinline__ float pairmax(float m) { auto rr = __builtin_amdgcn_permlane32_swap(__float_as_uint(m), __float_as_uint(m), false, false); return __builtin_fmaxf(__uint_as_float(rr[0]), __uint_as_float(rr[1])); }
__device__ __forceinline__ float rowmax32(const f32x16& p0, const f32x16& p1) {
    float a = max3f(p0[0], p0[1], p1[0]), b = max3f(p0[2], p0[3], p1[1]); a = max3f(a, p1[2], p1[3]);
#pragma unroll
    for (int r = 4; r < 16; r += 4) { a = max3f(a, p0[r], p0[r + 1]); b = max3f(b, p0[r + 2], p0[r + 3]); a = max3f(a, p1[r], p1[r + 1]); b = max3f(b, p1[r + 2], p1[r + 3]); }
    return pairmax(__builtin_fmaxf(a, b));
}
#define SBAR() __builtin_amdgcn_sched_barrier(0)
#define PIN(x) asm volatile("" : "+v"(x))
#define VCHUNK(PC, KB, R) do { \
        float e0_ = __builtin_amdgcn_exp2f(PC[(R)]), e1_ = __builtin_amdgcn_exp2f(PC[(R) + 1]), e2_ = __builtin_amdgcn_exp2f(PC[(R) + 2]), e3_ = __builtin_amdgcn_exp2f(PC[(R) + 3]); \
        s0 += e0_; s1 += e1_; s2 += e2_; s3 += e3_; pw[KB][(R) / 2] = cvtpk(e0_, e1_); pw[KB][(R) / 2 + 1] = cvtpk(e2_, e3_); \
        PIN(pw[KB][(R) / 2]); PIN(pw[KB][(R) / 2 + 1]); } while (0)
#define VTR4(J) do { const LAS unsigned char* vb_ = vc + (J) * 1024; va0 = vtr(vb_); va1 = vtr(vb_ + 512); vb0 = vtr(vb_ + 4096); vb1 = vtr(vb_ + 4096 + 512); } while (0)
#define PVJ(J) do { const u32x4 pbw_ = {pw[(J) >> 1][4 * ((J) & 1)], pw[(J) >> 1][4 * ((J) & 1) + 1], pw[(J) >> 1][4 * ((J) & 1) + 2], pw[(J) >> 1][4 * ((J) & 1) + 3]}; \
        const bf16x8 pb_ = __builtin_bit_cast(bf16x8, pbw_); \
        const bf16x8 fa_ = {va0[0], va0[1], va0[2], va0[3], va1[0], va1[1], va1[2], va1[3]}; const bf16x8 fb_ = {vb0[0], vb0[1], vb0[2], vb0[3], vb1[0], vb1[1], vb1[2], vb1[3]}; \
        o0 = MFMA32(fa_, pb_, o0); o1 = MFMA32(fb_, pb_, o1); } while (0)
#define ASTEP(T, PC0, PC1, PN0, PN1, KRO, VRO, KRN, VRN) do { \
        const int t_ = (T); \
        if (t_ + 3 < NT) KRN = *(const u32x4*)(ksrc + (size_t)(t_ + 3) * 64 * EVEN_IN); \
        if (t_ + 2 < NT) VRN = *(const u32x4*)(vsrc + (size_t)(t_ + 2) * 64 * EVEN_IN); \
        const LAS unsigned char* kn = lds + ((t_ + 1) & 1) * 8192 + koff; \
        const LAS unsigned char* vc = lds + (t_ & 1) * 8192 + voff; \
        bf16x8 kf[8]; \
        _Pragma("unroll") for (int d0 = 0; d0 < 4; ++d0) { kf[2 * d0] = *(const LAS bf16x8*)(kn + d0 * 2048); kf[2 * d0 + 1] = *(const LAS bf16x8*)(kn + d0 * 2048 + 512); } \
        unsigned pw[2][8]; float s0 = 0.f, s1 = 0.f, s2 = 0.f, s3 = 0.f; s16x4 va0, va1, vb0, vb1; \
        SBAR(); \
        VCHUNK(PC0, 0, 0); VCHUNK(PC1, 1, 0); SBAR(); \
        PN0 = MFMA32(kf[0], qf[0], negm); VCHUNK(PC0, 0, 4); SBAR(); \
        PN1 = MFMA32(kf[1], qf[0], negm); VCHUNK(PC1, 1, 4); SBAR(); \
        PN0 = MFMA32(kf[2], qf[1], PN0); VCHUNK(PC0, 0, 8); SBAR(); \
        PN1 = MFMA32(kf[3], qf[1], PN1); VCHUNK(PC1, 1, 8); SBAR(); \
        PN0 = MFMA32(kf[4], qf[2], PN0); VCHUNK(PC0, 0, 12); SBAR(); \
        PN1 = MFMA32(kf[5], qf[2], PN1); VCHUNK(PC1, 1, 12); SBAR(); \
        PN0 = MFMA32(kf[6], qf[3], PN0); VTR4(0); lsum += (s0 + s1) + (s2 + s3); SBAR(); \
        PN1 = MFMA32(kf[7], qf[3], PN1); SBAR(); \
        PVJ(0); VTR4(1); \
        float ma_ = max3f(PN0[0], PN0[1], PN0[2]); ma_ = max3f(ma_, PN0[3], PN0[4]); ma_ = max3f(ma_, PN0[5], PN0[6]); ma_ = max3f(ma_, PN0[7], PN0[8]); PIN(ma_); SBAR(); \
        PVJ(1); VTR4(2); \
        ma_ = max3f(ma_, PN0[9], PN0[10]); ma_ = max3f(ma_, PN0[11], PN0[12]); ma_ = max3f(ma_, PN0[13], PN0[14]); ma_ = max3f(ma_, PN0[15], PN1[0]); PIN(ma_); SBAR(); \
        PVJ(2); VTR4(3); \
        float mb_ = max3f(PN1[1], PN1[2], PN1[3]); mb_ = max3f(mb_, PN1[4], PN1[5]); mb_ = max3f(mb_, PN1[6], PN1[7]); mb_ = max3f(mb_, PN1[8], PN1[9]); PIN(mb_); SBAR(); \
        PVJ(3); \
        mb_ = max3f(mb_, PN1[10], PN1[11]); mb_ = max3f(mb_, PN1[12], PN1[13]); mb_ = max3f(mb_, PN1[14], PN1[15]); \
        const float mt_ = pairmax(__builtin_fmaxf(ma_, mb_)); \
        SBAR(); \
        if (t_ + 2 < NT) *(LAS u32x4*)(lds + (t_ & 1) * 8192 + kdst) = KRO; \
        if (t_ + 1 < NT) *(LAS u32x4*)(lds + ((t_ + 1) & 1) * 8192 + vdst) = VRO; \
        if (__builtin_amdgcn_ballot_w64(mt_ > THR) != 0ull) { \
            const float d_ = __builtin_fmaxf(mt_, 0.f), alpha_ = __builtin_amdgcn_exp2f(-d_); \
            mref += d_; lsum *= alpha_; \
            _Pragma("unroll") for (int r = 0; r < 16; ++r) { o0[r] *= alpha_; o1[r] *= alpha_; PN0[r] -= d_; PN1[r] -= d_; negm[r] = -mref; } \
        } \
        ABAR(); } while (0)
__device__ __forceinline__ void attn_unit(LAS unsigned char* lds, bf16_t* P, const float* qgain, const float* rope, int s, int h, int qb, int lane, int wid, bool dry) {
    const int r32 = lane & 31, hi = lane >> 5, kvh = h >> 2;
    const size_t rowbase = (size_t)s * SEQ;
    const bf16_t* ksrc = P + (rowbase + lane) * EVEN_IN + 1536 + kvh * 64 + wid * 8;
    const bf16_t* vsrc = P + (rowbase + 16 * (wid & 3) + (lane >> 2)) * EVEN_IN + 1664 + kvh * 64 + (wid >> 2) * 32 + (lane & 3) * 8;
    const int kdst = wid * 1024 + lane * 16;
    const int vdst = 16384 + (wid >> 2) * 4096 + (16 * (wid & 3) + (lane >> 2)) * 64 + (lane & 3) * 16;
    const size_t qrow = rowbase + (size_t)qb * 256 + wid * 32 + r32;
    const bf16_t* qg = P + qrow * EVEN_IN + 1024 + h * 64 + hi * 8;
    u32x4 krA = *(const u32x4*)ksrc, vrA = *(const u32x4*)vsrc;
    u32x4 krB = *(const u32x4*)(ksrc + (size_t)64 * EVEN_IN), vrB;
    bf16x8 qf[4];
    {
        float y[4][8]; float ssq = 0.f;
#pragma unroll
        for (int d0 = 0; d0 < 4; ++d0) { const u32x4 w = *(const u32x4*)(qg + d0 * 16);
            y[d0][0] = bflo(w.x); y[d0][1] = bfhi(w.x); y[d0][2] = bflo(w.y); y[d0][3] = bfhi(w.y); y[d0][4] = bflo(w.z); y[d0][5] = bfhi(w.z); y[d0][6] = bflo(w.w); y[d0][7] = bfhi(w.w);
#pragma unroll
            for (int e = 0; e < 8; ++e) ssq += y[d0][e] * y[d0][e]; }
        { const auto rr = __builtin_amdgcn_permlane32_swap(__float_as_uint(ssq), __float_as_uint(ssq), false, false); ssq = __uint_as_float(rr[0]) + __uint_as_float(rr[1]); }
        const float rh = __builtin_amdgcn_rsqf(ssq * (1.0f / 64.0f) + EPS) * C2;
        const int tq = qb * 256 + wid * 32 + r32;
#pragma unroll
        for (int d0 = 0; d0 < 4; ++d0) { const f32x4 g0 = *(const f32x4*)(qgain + d0 * 16 + hi * 8), g1 = *(const f32x4*)(qgain + d0 * 16 + hi * 8 + 4);
#pragma unroll
            for (int e = 0; e < 8; ++e) y[d0][e] *= rh * (e < 4 ? g0[e & 3] : g1[e & 3]); }
#pragma unroll
        for (int hf = 0; hf < 2; ++hf) {
            const int ir = hf ? (tq & 63) : (tq >> 6);
            const f32x4 c0 = *(const f32x4*)(rope + ir * 16 + 8 * hi), c1 = *(const f32x4*)(rope + ir * 16 + 8 * hi + 4);
            const f32x4 s0 = *(const f32x4*)(rope + 1024 + ir * 16 + 8 * hi), s1 = *(const f32x4*)(rope + 1024 + ir * 16 + 8 * hi + 4);
            u32x4 wa, wb; unsigned* pa = (unsigned*)&wa; unsigned* pb = (unsigned*)&wb; (void)pa; (void)pb;
            float oa[8], ob[8];
#pragma unroll
            for (int e = 0; e < 8; ++e) { const float c = (e < 4 ? c0[e & 3] : c1[e & 3]), sn = (e < 4 ? s0[e & 3] : s1[e & 3]); const float x1 = y[2 * hf][e], x2 = y[2 * hf + 1][e];
                oa[e] = x1 * c - x2 * sn; ob[e] = x2 * c + x1 * sn; }
            wa.x = cvt_pk_bf16(oa[0], oa[1]); wa.y = cvt_pk_bf16(oa[2], oa[3]); wa.z = cvt_pk_bf16(oa[4], oa[5]); wa.w = cvt_pk_bf16(oa[6], oa[7]);
            wb.x = cvt_pk_bf16(ob[0], ob[1]); wb.y = cvt_pk_bf16(ob[2], ob[3]); wb.z = cvt_pk_bf16(ob[4], ob[5]); wb.w = cvt_pk_bf16(ob[6], ob[7]);
            qf[2 * hf] = __builtin_bit_cast(bf16x8, wa); qf[2 * hf + 1] = __builtin_bit_cast(bf16x8, wb);
        }
    }
    *(LAS u32x4*)(lds + kdst) = krA; *(LAS u32x4*)(lds + vdst) = vrA; *(LAS u32x4*)(lds + 8192 + kdst) = krB;
    asm volatile("s_waitcnt vmcnt(0) lgkmcnt(0)\n\ts_barrier" ::: "memory");
    krA = *(const u32x4*)(ksrc + (size_t)2 * 64 * EVEN_IN); vrA = *(const u32x4*)(vsrc + (size_t)64 * EVEN_IN);
    const int koff = hi * 1024 + r32 * 16;
    const int voff = 16384 + ((lane >> 4) & 1) * 32 + (lane & 3) * 8 + (4 * hi + ((lane & 15) >> 2)) * 64;
    float mref, lsum = 0.f;
    f32x16 o0 = {}, o1 = {}, pA0 = {}, pA1 = {}, pB0, pB1;
    {
#pragma unroll
        for (int d0 = 0; d0 < 4; ++d0) {
            const bf16x8 k0 = *(const LAS bf16x8*)(lds + koff + d0 * 2048), k1 = *(const LAS bf16x8*)(lds + koff + d0 * 2048 + 512);
            pA0 = MFMA32(k0, qf[d0], pA0); pA1 = MFMA32(k1, qf[d0], pA1);
        }
        mref = rowmax32(pA0, pA1);
#pragma unroll
        for (int r = 0; r < 16; ++r) { pA0[r] -= mref; pA1[r] -= mref; }
    }
    f32x16 negm;
#pragma unroll
    for (int r = 0; r < 16; ++r) negm[r] = -mref;
    constexpr int NT = SEQ / 64;
    constexpr float THR = 8.0f;
    for (int t = 0; t < NT; t += 2) {
        ASTEP(t, pA0, pA1, pB0, pB1, krA, vrA, krB, vrB);
        ASTEP(t + 1, pB0, pB1, pA0, pA1, krB, vrB, krA, vrA);
    }
    lsum += __shfl_xor(lsum, 32);
    const float inv = 1.0f / lsum;
    bf16_t* op = P + qrow * EVEN_IN + 1792 + h * 64 + 4 * hi;
    u32x2 zq[8];
#pragma unroll
    for (int i = 0; i < 4; ++i) { zq[i] = *(const u32x2*)(op + 8 * i); zq[4 + i] = *(const u32x2*)(op + 32 + 8 * i); }
    if (!dry)
#pragma unroll
    for (int i = 0; i < 4; ++i) {
        { const u32x2 z = zq[i]; u32x2 w;
          w.x = cvt_pk_bf16(o0[4 * i] * inv * silu_f(bflo(z.x)), o0[4 * i + 1] * inv * silu_f(bfhi(z.x))); w.y = cvt_pk_bf16(o0[4 * i + 2] * inv * silu_f(bflo(z.y)), o0[4 * i + 3] * inv * silu_f(bfhi(z.y))); *(u32x2*)(op + 8 * i) = w; }
        { const u32x2 z = zq[4 + i]; u32x2 w;
          w.x = cvt_pk_bf16(o1[4 * i] * inv * silu_f(bflo(z.x)), o1[4 * i + 1] * inv * silu_f(bfhi(z.x))); w.y = cvt_pk_bf16(o1[4 * i + 2] * inv * silu_f(bflo(z.y)), o1[4 * i + 3] * inv * silu_f(bfhi(z.y))); *(u32x2*)(op + 32 + 8 * i) = w; }
    }
}

__device__ __forceinline__ void pool_loadU(u32x4 (&ur)[10], const bf16_t* P, int it, int tid) {
    const int t0 = (it & 63) * 64; const size_t rowbase = (size_t)(it >> 6) * SEQ;
#pragma unroll
    for (int i = 0; i < 10; ++i) {
        const int idx = tid + 512 * i, row = idx >> 6, ch = idx & 63, t = t0 - 8 + row;
        u32x4 v = {0u, 0u, 0u, 0u};
        if (t >= 0 && t < SEQ) v = *(const u32x4*)(P + (rowbase + t) * EVEN_IN + ch * 8);
        ur[i] = v;
    }
}
__device__ __forceinline__ void pool_run(LAS unsigned char* lds, bf16_t* P, const bf16_t* pwT, const float* pscale, int it0, int step, int tid, int lane, int wid, bool dry) {
    LAS unsigned char* U = lds; LAS unsigned char* DF = lds + 81920;
    u32x4 ur[10];
    if (it0 < 768) pool_loadU(ur, P, it0, tid);
    for (int it = it0; it < 768; it += step) {
    const int t0 = (it & 63) * 64; const size_t rowbase = (size_t)(it >> 6) * SEQ;
    u32x2 zz[8][2];
    { const int g = wid >> 1, th = wid & 1, fr = lane & 15, fq = lane >> 4;
#pragma unroll
      for (int db = 0; db < 8; ++db)
#pragma unroll
          for (int tb = 0; tb < 2; ++tb)
              zz[db][tb] = *(const u32x2*)(P + (rowbase + t0 + 32 * th + 16 * tb + fr) * EVEN_IN + 512 + g * 128 + 16 * db + 4 * fq); }
#pragma unroll
    for (int i = 0; i < 10; ++i) { const int idx = tid + 512 * i; *(LAS u32x4*)(U + (idx >> 6) * 1024 + (idx & 63) * 16) = ur[i]; }
    __syncthreads();
    if (it + step < 768) pool_loadU(ur, P, it + step, tid);
    bf16x8 af0[8];
    { const int g = wid >> 1, fr = lane & 15, fq = lane >> 4;
#pragma unroll
      for (int db = 0; db < 8; ++db) af0[db] = *(const bf16x8*)(pwT + ((size_t)(g * 128 + 16 * db + fr) * 128 + 8 * fq)); }
    {
        const int cp = tid & 255, half = tid >> 8, g = cp >> 6, w2 = 1 << g, tl0 = half * 32;
        const LAS unsigned* U32 = (const LAS unsigned*)U; LAS unsigned* D32 = (LAS unsigned*)DF;
        float sx = 0.f, sy = 0.f;
        for (int r = tl0 + 8 - w2; r < tl0 + 8 + w2; ++r) { const unsigned w = U32[r * 256 + cp]; sx += bflo(w); sy += bfhi(w); }
#pragma unroll 8
        for (int i = 0; i < 32; ++i) {
            const int tl = tl0 + i, t = t0 + tl;
            const int lo = (t - w2) < 0 ? 0 : (t - w2), hi2 = (t + w2) > SEQ ? SEQ : (t + w2);
            const float inv = 1.0f / (float)(hi2 - lo);
            const unsigned w = U32[(tl + 8) * 256 + cp];
            D32[tl * 260 + cp] = cvt_pk_bf16(sx * inv - bflo(w), sy * inv - bfhi(w));
            const unsigned wa = U32[(tl + 8 + w2) * 256 + cp], wb = U32[(tl + 8 - w2) * 256 + cp];
            sx += bflo(wa) - bflo(wb); sy += bfhi(wa) - bfhi(wb);
        }
    }
    __syncthreads();
    {
        const int g = wid >> 1, th = wid & 1, fr = lane & 15, fq = lane >> 4;
        f32x4 acc[8][2];
#pragma unroll
        for (int db = 0; db < 8; ++db) { acc[db][0] = (f32x4){0.f, 0.f, 0.f, 0.f}; acc[db][1] = (f32x4){0.f, 0.f, 0.f, 0.f}; }
#pragma unroll
        for (int ks = 0; ks < 4; ++ks) {
            const bf16x8 b0 = *(const LAS bf16x8*)(DF + (32 * th + fr) * 1040 + (g * 128 + 32 * ks + 8 * fq) * 2);
            const bf16x8 b1 = *(const LAS bf16x8*)(DF + (32 * th + 16 + fr) * 1040 + (g * 128 + 32 * ks + 8 * fq) * 2);
#pragma unroll
            for (int db = 0; db < 8; ++db) {
                const bf16x8 af = (ks == 0) ? af0[db] : *(const bf16x8*)(pwT + ((size_t)(g * 128 + 16 * db + fr) * 128 + 32 * ks + 8 * fq));
                acc[db][0] = MFMA16(af, b0, acc[db][0]); acc[db][1] = MFMA16(af, b1, acc[db][1]);
            }
        }
#pragma unroll
        for (int db = 0; db < 8; ++db) {
            const int col = g * 128 + 16 * db + 4 * fq;
            const f32x4 sc = *(const f32x4*)(pscale + col);
#pragma unroll
            for (int tb = 0; tb < 2; ++tb) {
                const int t = 32 * th + 16 * tb + fr;
                u32x2* pp = (u32x2*)(P + (rowbase + t0 + t) * EVEN_IN + 512 + col);
                const u32x2 z = zz[db][tb]; const f32x4 a = acc[db][tb] * sc; u32x2 w;
                w.x = cvt_pk_bf16(a[0] * silu_f(bflo(z.x)), a[1] * silu_f(bfhi(z.x))); w.y = cvt_pk_bf16(a[2] * silu_f(bflo(z.y)), a[3] * silu_f(bfhi(z.y))); if (!dry) *pp = w;
            }
        }
    }
    __syncthreads();
    }
}

__device__ __forceinline__ void sgu_item(LAS unsigned char* lds, bf16_t* P, const bf16_t* wsb, const float* bs, const float* sg, const float* ssv, int ch, int h, bool load_w, int tid, int lane, int wid, bool dry) {
    LAS unsigned char* GV = lds; LAS unsigned char* WT = lds + 36864; LAS unsigned char* GU = lds + 71680; LAS unsigned char* SZ = lds + 106496;
    const size_t row0 = (size_t)ch * 128;
#pragma unroll
    for (int i = 0; i < 4; ++i) {
        const int idx = tid + 512 * i, r = idx >> 4, c16 = idx & 15;
        const bf16_t* src = P + (row0 + r) * ODD_IN + h * 128 + c16 * 8;
        const u32x4 gu = *(const u32x4*)src, gv = *(const u32x4*)(src + 1024), sz = *(const u32x4*)(src + 2048);
        float part = ssv[(row0 + r) * 16 + c16];
        part += __shfl_xor(part, 1); part += __shfl_xor(part, 2); part += __shfl_xor(part, 4); part += __shfl_xor(part, 8);
        const float rv = __builtin_amdgcn_rsqf(part * (1.0f / 1024.0f) + EPS);
        const f32x4 g0 = *(const f32x4*)(sg + h * 128 + c16 * 8) * rv, g1 = *(const f32x4*)(sg + h * 128 + c16 * 8 + 4) * rv;
        u32x4 gn;
        gn.x = cvt_pk_bf16(bflo(gv.x) * g0[0], bfhi(gv.x) * g0[1]); gn.y = cvt_pk_bf16(bflo(gv.y) * g0[2], bfhi(gv.y) * g0[3]);
        gn.z = cvt_pk_bf16(bflo(gv.z) * g1[0], bfhi(gv.z) * g1[1]); gn.w = cvt_pk_bf16(bflo(gv.w) * g1[2], bfhi(gv.w) * g1[3]);
        *(LAS u32x4*)(GV + r * 288 + c16 * 16) = gn;
        *(LAS u32x4*)(GU + r * 272 + c16 * 16) = gu;
        *(LAS u32x4*)(SZ + r * 272 + c16 * 16) = sz;
        if (load_w) *(LAS u32x4*)(WT + r * 272 + c16 * 16) = *(const u32x4*)(wsb + ((size_t)(h * 128 + r) * 128 + c16 * 8));
    }
    __syncthreads();
    {
        const int fr = lane & 15, fq = lane >> 4;
        bf16x8 af[4];
#pragma unroll
        for (int ks = 0; ks < 4; ++ks) {
            const LAS unsigned char* ap = GV + (32 * ks + 8 * fq + (fr >> 2)) * 288 + (16 * wid + 4 * (fr & 3)) * 2;
            const s16x4 a0 = vtr(ap), a1 = vtr(ap + 4 * 288);
            af[ks] = (bf16x8){a0[0], a0[1], a0[2], a0[3], a1[0], a1[1], a1[2], a1[3]};
        }
        f32x4 acc[8];
#pragma unroll
        for (int pb = 0; pb < 8; ++pb) acc[pb] = (f32x4){0.f, 0.f, 0.f, 0.f};
#pragma unroll
        for (int ks = 0; ks < 4; ++ks)
#pragma unroll
            for (int pb = 0; pb < 8; ++pb) {
                const bf16x8 bfr = *(const LAS bf16x8*)(WT + (16 * pb + fr) * 272 + (32 * ks + 8 * fq) * 2);
                acc[pb] = MFMA16(af[ks], bfr, acc[pb]);
            }
#pragma unroll
        for (int pb = 0; pb < 8; ++pb) {
            const int p = 16 * pb + fr; const float bias = bs[h * 128 + p];
            LAS u32x2* gp = (LAS u32x2*)(GU + p * 272 + (16 * wid + 4 * fq) * 2);
            const u32x2 gu = *gp, sz = *(const LAS u32x2*)(SZ + p * 272 + (16 * wid + 4 * fq) * 2);
            u32x2 w;
            const f32x4 ug = gelu4((f32x4){bflo(gu.x), bfhi(gu.x), bflo(gu.y), bfhi(gu.y)});
            const f32x4 zs = silu4((f32x4){bflo(sz.x), bfhi(sz.x), bflo(sz.y), bfhi(sz.y)});
            w.x = cvt_pk_bf16(ug[0] * (acc[pb][0] + bias) * zs[0], ug[1] * (acc[pb][1] + bias) * zs[1]);
            w.y = cvt_pk_bf16(ug[2] * (acc[pb][2] + bias) * zs[2], ug[3] * (acc[pb][3] + bias) * zs[3]);
            *gp = w;
        }
    }
    __syncthreads();
#pragma unroll
    for (int i = 0; i < 4; ++i) {
        const int idx = tid + 512 * i, r = idx >> 4, c16 = idx & 15;
        if (!dry) *(u32x4*)(P + (row0 + r) * ODD_IN + h * 128 + c16 * 8) = *(const LAS u32x4*)(GU + r * 272 + c16 * 16);
    }
    __syncthreads();
}


__device__ __forceinline__ void sgu_load(u32x4 (&gu)[4], u32x4 (&gv)[4], u32x4 (&sz)[4], float (&part)[4], const bf16_t* P, const float* ssv, int ch, int h, int tid) {
    const size_t row0 = (size_t)ch * 128;
#pragma unroll
    for (int i = 0; i < 4; ++i) {
        const int idx = tid + 512 * i, r = idx >> 4, c16 = idx & 15;
        const bf16_t* src = P + (row0 + r) * ODD_IN + h * 128 + c16 * 8;
        gu[i] = *(const u32x4*)src; gv[i] = *(const u32x4*)(src + 1024); sz[i] = *(const u32x4*)(src + 2048);
        part[i] = ssv[(row0 + r) * 16 + c16];
    }
}
__device__ __forceinline__ void sgu_run(LAS unsigned char* lds, bf16_t* P, const bf16_t* wsb, const float* bs, const float* sg, const float* ssv, int ch0, int cstep, int h, int tid, int lane, int wid, bool dry) {
    LAS unsigned char* GV = lds; LAS unsigned char* WT = lds + 36864; LAS unsigned char* GU = lds + 71680; LAS unsigned char* SZ = lds + 106496;
    u32x4 gu[4], gv[4], sz[4]; float part[4];
    if (ch0 < 384) sgu_load(gu, gv, sz, part, P, ssv, ch0, h, tid);
    bool first = true;
    for (int ch = ch0; ch < 384; ch += cstep) {
        const size_t row0 = (size_t)ch * 128;
#pragma unroll
        for (int i = 0; i < 4; ++i) {
            const int idx = tid + 512 * i, r = idx >> 4, c16 = idx & 15;
            float pt = part[i];
            pt += __shfl_xor(pt, 1); pt += __shfl_xor(pt, 2); pt += __shfl_xor(pt, 4); pt += __shfl_xor(pt, 8);
            const float rv = __builtin_amdgcn_rsqf(pt * (1.0f / 1024.0f) + EPS);
            const f32x4 g0 = *(const f32x4*)(sg + h * 128 + c16 * 8) * rv, g1 = *(const f32x4*)(sg + h * 128 + c16 * 8 + 4) * rv;
            u32x4 gn;
            gn.x = cvt_pk_bf16(bflo(gv[i].x) * g0[0], bfhi(gv[i].x) * g0[1]); gn.y = cvt_pk_bf16(bflo(gv[i].y) * g0[2], bfhi(gv[i].y) * g0[3]);
            gn.z = cvt_pk_bf16(bflo(gv[i].z) * g1[0], bfhi(gv[i].z) * g1[1]); gn.w = cvt_pk_bf16(bflo(gv[i].w) * g1[2], bfhi(gv[i].w) * g1[3]);
            *(LAS u32x4*)(GV + r * 288 + c16 * 16) = gn;
            *(LAS u32x4*)(GU + r * 272 + c16 * 16) = gu[i];
            *(LAS u32x4*)(SZ + r * 272 + c16 * 16) = sz[i];
            if (first) *(LAS u32x4*)(WT + r * 272 + c16 * 16) = *(const u32x4*)(wsb + ((size_t)(h * 128 + r) * 128 + c16 * 8));
        }
        first = false;
        __syncthreads();
        if (ch + cstep < 384) sgu_load(gu, gv, sz, part, P, ssv, ch + cstep, h, tid);
        {
            const int fr = lane & 15, fq = lane >> 4;
            bf16x8 af[4];
#pragma unroll
            for (int ks = 0; ks < 4; ++ks) {
                const LAS unsigned char* ap = GV + (32 * ks + 8 * fq + (fr >> 2)) * 288 + (16 * wid + 4 * (fr & 3)) * 2;
                const s16x4 a0 = vtr(ap), a1 = vtr(ap + 4 * 288);
                af[ks] = (bf16x8){a0[0], a0[1], a0[2], a0[3], a1[0], a1[1], a1[2], a1[3]};
            }
            f32x4 acc[8];
#pragma unroll
            for (int pb = 0; pb < 8; ++pb) acc[pb] = (f32x4){0.f, 0.f, 0.f, 0.f};
#pragma unroll
            for (int ks = 0; ks < 4; ++ks)
#pragma unroll
                for (int pb = 0; pb < 8; ++pb) {
                    const bf16x8 bfr = *(const LAS bf16x8*)(WT + (16 * pb + fr) * 272 + (32 * ks + 8 * fq) * 2);
                    acc[pb] = MFMA16(af[ks], bfr, acc[pb]);
                }
#pragma unroll
            for (int pb = 0; pb < 8; ++pb) {
                const int p = 16 * pb + fr; const float bias = bs[h * 128 + p];
                LAS u32x2* gp = (LAS u32x2*)(GU + p * 272 + (16 * wid + 4 * fq) * 2);
                const u32x2 gu2 = *gp, sz2 = *(const LAS u32x2*)(SZ + p * 272 + (16 * wid + 4 * fq) * 2);
                u32x2 w;
                const f32x4 ug = gelu4((f32x4){bflo(gu2.x), bfhi(gu2.x), bflo(gu2.y), bfhi(gu2.y)});
                const f32x4 zs = silu4((f32x4){bflo(sz2.x), bfhi(sz2.x), bflo(sz2.y), bfhi(sz2.y)});
                w.x = cvt_pk_bf16(ug[0] * (acc[pb][0] + bias) * zs[0], ug[1] * (acc[pb][1] + bias) * zs[1]);
                w.y = cvt_pk_bf16(ug[2] * (acc[pb][2] + bias) * zs[2], ug[3] * (acc[pb][3] + bias) * zs[3]);
                *gp = w;
            }
        }
        __syncthreads();
#pragma unroll
        for (int i = 0; i < 4; ++i) {
            const int idx = tid + 512 * i, r = idx >> 4, c16 = idx & 15;
            if (!dry) *(u32x4*)(P + (row0 + r) * ODD_IN + h * 128 + c16 * 8) = *(const LAS u32x4*)(GU + r * 272 + c16 * 16);
        }
        __syncthreads();
    }
}

#define XB_TMO      128
#define XB_XCNT(j)  (256  + 64 * (j))
#define XB_XSUB(j)  (1280 + 64 * (j))
#define XB_XGEN(j)  (2304 + 64 * (j))
#define XB_TOP      3328
#define XB_TOPGEN   3392
#define XCD_BAR_WORDS 3456
#define XB_SPIN_CAP (1u << 18)

__device__ __forceinline__ unsigned xb_ld(unsigned* p)              { return __hip_atomic_load(p, __ATOMIC_RELAXED, __HIP_MEMORY_SCOPE_AGENT); }
__device__ __forceinline__ unsigned xb_add(unsigned* p, unsigned v) { return __hip_atomic_fetch_add(p, v, __ATOMIC_RELAXED, __HIP_MEMORY_SCOPE_AGENT); }
__device__ __forceinline__ unsigned xb_xcc_id() { return (unsigned)__builtin_amdgcn_s_getreg((3 << 11) | 20) & 0xFu; }
#define XB_SPIN(cond, bar) do { unsigned _sp = 0; while (cond) { __builtin_amdgcn_s_sleep(1); \
    if ((++_sp & 255u) == 0u) { if (xb_ld(&(bar)[XB_TMO])) break; if (_sp > XB_SPIN_CAP) { atomicAdd(&(bar)[XB_TMO], 1u); break; } } } } while (0)

struct XcdBarrier {
    unsigned* bar; unsigned x;
    volatile LAS unsigned* st;
};

__device__ __forceinline__ XcdBarrier xcd_barrier_post(unsigned* bar, volatile LAS unsigned* st) {
    XcdBarrier b; b.bar = bar; b.x = xb_xcc_id(); b.st = st;
    if (threadIdx.x == 0) st[2] = xb_add(&bar[XB_XCNT(b.x)], 1u) + 1u;
    return b;
}
__device__ __forceinline__ void xcd_barrier_complete(unsigned* bar, unsigned x, unsigned& nloc, unsigned& nx) {
    const unsigned G = gridDim.x * gridDim.y * gridDim.z;
    unsigned sum, cnt, mine, sp = 0u;
    for (;;) {
        sum = 0u; cnt = 0u; mine = 0u;
#pragma unroll
        for (unsigned j = 0; j < 16; ++j) { const unsigned c = xb_ld(&bar[XB_XCNT(j)]); sum += c; cnt += (c > 0u) ? 1u : 0u; mine = (j == x) ? c : mine; }
        if (sum == G) break;
        __builtin_amdgcn_s_sleep(1);
        if ((++sp & 255u) == 0u) { if (xb_ld(&bar[XB_TMO])) break; if (sp > XB_SPIN_CAP) { atomicAdd(&bar[XB_TMO], 1u); break; } }
    }
    nloc = mine > 0u ? mine : 1u; nx = cnt > 0u ? cnt : 1u;
}

__device__ __forceinline__ void xcd_barrier(const XcdBarrier& b) {
    asm volatile("s_waitcnt vmcnt(0)" ::: "memory");
    __syncthreads();
    if (threadIdx.x == 0) {
        unsigned* bar = b.bar;
        __builtin_amdgcn_s_waitcnt(0);
        unsigned nloc = b.st[0], nx = b.st[1];
        if (nloc == 0u) { xcd_barrier_complete(bar, b.x, nloc, nx); b.st[0] = nloc; b.st[1] = nx; }
        const unsigned old = xb_add(&bar[XB_XSUB(b.x)], 1u);
        const unsigned gen = old / nloc;
        if (old + 1u == (gen + 1u) * nloc) {
            __builtin_amdgcn_fence(__ATOMIC_RELEASE, "agent");
            asm volatile("s_waitcnt vmcnt(0)" ::: "memory");
            const unsigned og = xb_add(&bar[XB_TOP], 1u);
            const unsigned tg = og / nx;
            if (og + 1u == (tg + 1u) * nx) xb_add(&bar[XB_TOPGEN], 1u);
            else XB_SPIN(xb_ld(&bar[XB_TOPGEN]) == tg, bar);
            __builtin_amdgcn_fence(__ATOMIC_ACQUIRE, "agent");
            xb_add(&bar[XB_XGEN(b.x)], 1u);
            asm volatile("s_waitcnt vmcnt(0)" ::: "memory");
        } else {
            XB_SPIN(xb_ld(&bar[XB_XGEN(b.x)]) == gen, bar);
            __builtin_amdgcn_fence(__ATOMIC_ACQUIRE, "agent");
            asm volatile("s_waitcnt vmcnt(0)" ::: "memory");
        }
    }
    __syncthreads();
}

#ifdef DIAG
#define DG(k) (DIAG == (k))
#else
#define DG(k) true
#endif
__global__ void __launch_bounds__(512, 2) fwd_kernel(Args a) {
    extern __shared__ __attribute__((aligned(16))) unsigned char lds_raw[];
    LAS unsigned char* lds = (LAS unsigned char*)lds_raw;
    const int wid = __builtin_amdgcn_readfirstlane(threadIdx.x >> 6);
    const int G = gridDim.x, bx0 = blockIdx.x;
    int bx = bx0;
    unsigned char* ws = a.ws;
    bf16_t* P = (bf16_t*)(ws + WS_P); bf16_t* XB = (bf16_t*)(ws + WS_XB);
    float* SS = (float*)(ws + WS_SS); float* SSV = (float*)(ws + WS_SSV);
    const float* rope = (const float*)(ws + WS_ROPE);
    if (threadIdx.x < 4) ((LAS unsigned*)(lds + BARW_OFF))[threadIdx.x] = 0u;
    __syncthreads();
    XcdBarrier xbar = xcd_barrier_post((unsigned*)(ws + WS_BAR), (volatile LAS unsigned*)(lds + BARW_OFF));
    for (int ph = a.ph_lo; ph < a.ph_hi; ++ph) {
        if (ph > 0 && ((ph - 1) & 3) == 1 && (((ph - 1) >> 2) & 1)) continue;
#ifdef PROBE_KIND
        const int kind = (ph == 0) ? 0 : ((((ph - 1) & 3) == 2) ? ((((ph - 1) >> 2) & 1) ? 3 : 2) : 1);
        const int nrep = (kind == PROBE_KIND && a.ph_lo == 0) ? 2 : 1;
#else
        const int nrep = 1;
#endif
        for (int rep = 0; rep < nrep; ++rep) {
        const bool dry = (rep + 1 < nrep);
        if (rep) { __syncthreads(); cg::this_grid().sync(); }
        int tid = threadIdx.x; asm volatile("" : "+v"(tid));
        const int lane = tid & 63;
        if (ph == 0) {
            if (DG(0)) prologue(a, lds, tid, lane, wid);
            __syncthreads();
        } else {
            const int layer = (ph - 1) >> 2, sub4 = (ph - 1) & 3, j = layer >> 1; const bool even = (layer & 1) == 0;
            const int sub = (sub4 == 0) ? 0 : (sub4 == 1 ? 3 : sub4 - 1);
            if (sub == 3) {
                kprep_phase(P, a.in[7] + j * 64, rope, tid, bx, G);
            } else if (sub == 0) {
                if (even) {
                    pg8::Gemm g{XB, (const bf16_t*)(ws + WS_WINE) + (size_t)j * 2304 * 1024, MTOK, EVEN_IN, 1024, 1024, 0};
                    pg8::StaticOrder S; S.init(MTOK, EVEN_IN, G, bx);
                    pg8::EpiEvenIn E{P, SS, (LAS float*)(lds + RST_OFF)};
                    if (DG(1)) pg8::gemm_phase(lds, g, S, E, tid);
                } else {
                    pg8::Gemm g{XB, (const bf16_t*)(ws + WS_WINO) + (size_t)j * 3072 * 1024, MTOK, ODD_IN, 1024, 1024, 0};
                    pg8::StaticOrder S; S.init(MTOK, ODD_IN, G, bx);
                    pg8::EpiOddIn E{P, SS, SSV, (LAS float*)(lds + RST_OFF)};
                    if (DG(2)) pg8::gemm_phase(lds, g, S, E, tid);
                }
            } else if (sub == 1) {
                if (even) {
                    const int x = bx & 7, y = bx >> 3, gpx = G >> 3;
                    const bool xcdmap = (G % 8 == 0);
                    for (int i = 0;; ++i) {
                        const int v = xcdmap ? ((i * 8 + x) * gpx + y) : (i * G + bx);
                        if (v >= 1536) break;
                        const int grp = v >> 6, w = v & 63;
                        if (DG(3)) attn_unit(lds, P, a.in[6] + j * 64, rope, grp >> 1, (grp & 1) * 4 + (w >> 4), w & 15, lane, wid, dry);
                    }
                    const bf16_t* pwT = (const bf16_t*)(ws + WS_POOLW) + (size_t)j * 4 * 128 * 128;
                    if (DG(4)) pool_run(lds, P, pwT, a.in[5] + j * 512, bx, G, tid, lane, wid, dry);
                } else {
                    const bf16_t* wsb = (const bf16_t*)(ws + WS_WSB) + (size_t)j * 8 * 128 * 128;
                    int hprev = -1;
                    if (G % 8 == 0) {
                        const int h = bx & 7;
                        if (DG(5)) sgu_run(lds, P, wsb, a.in[13] + j * 1024, a.in[11] + j * 1024, SSV, bx >> 3, G >> 3, h, tid, lane, wid, dry);
                    } else {
                        for (int it = bx; it < 3072; it += G) { const int h = it & 7; if (DG(5)) sgu_item(lds, P, wsb, a.in[13] + j * 1024, a.in[11] + j * 1024, SSV, it >> 3, h, h != hprev, tid, lane, wid, dry); hprev = h; }
                    }
                }
            } else {
                if (even) {
                    pg8::Gemm g{P + 512, (const bf16_t*)(ws + WS_WOUTE) + (size_t)j * 1024 * 1024, MTOK, 1024, 1024, EVEN_IN, 1536};
                    pg8::StaticOrder S; S.init(MTOK, 1024, G, bx);
                    pg8::EpiOut E{a.out, layer == 0 ? a.in[0] : a.out, layer == 0 ? a.in[1] - (size_t)MPROMPT * DM : a.out, XB, SS, dry, layer == 3};
                    if (DG(6)) pg8::gemm_phase(lds, g, S, E, tid);
                } else {
                    pg8::Gemm g{P, (const bf16_t*)(ws + WS_WOUTO) + (size_t)j * 1024 * 1024, MTOK, 1024, 1024, ODD_IN, 0};
                    pg8::StaticOrder S; S.init(MTOK, 1024, G, bx);
                    pg8::EpiOut E{a.out, layer == 0 ? a.in[0] : a.out, layer == 0 ? a.in[1] - (size_t)MPROMPT * DM : a.out, XB, SS, dry, layer == 3};
                    if (DG(6)) pg8::gemm_phase(lds, g, S, E, tid);
                }
            }
        }
        }
        if (ph + 1 < a.ph_hi) { if (a.ph_hi > NPHASE) cg::this_grid().sync(); else xcd_barrier(xbar); }
        if (ph == a.ph_lo && ph + 1 < a.ph_hi) {
            volatile LAS unsigned* st = (volatile LAS unsigned*)(lds + BARW_OFF);
            if (threadIdx.x == 0) {
                unsigned* bar = (unsigned*)(ws + WS_BAR); bool ok = (G % 8 == 0) && (xbar.x < 8u);
                for (unsigned jx = 0; jx < 8; ++jx) ok = ok && (xb_ld(&bar[XB_XCNT(jx)]) == (unsigned)(G / 8));
                st[3] = ok ? 1u : 0u;
            }
            __syncthreads();
            if (st[3]) bx = __builtin_amdgcn_readfirstlane((int)xbar.x + 8 * (int)(st[2] - 1u));
        }
    }
}

extern "C" void kernel_launch(void* const* d_in, const int* in_sizes, int n_in, void* d_out, int out_size, void* d_ws, size_t ws_size, hipStream_t stream) {
    static int grid = 0;
    if (grid == 0) {
        if (n_in != 15 || out_size != MTOK * DM || ws_size < WS_END) { fprintf(stderr, "kernel_launch: unexpected shapes (n_in %d out %d ws %zu need %zu)\n", n_in, out_size, ws_size, (size_t)WS_END); grid = -1; return; }
        int dev = 0, cus = 0, per_cu = 0;
        (void)hipGetDevice(&dev);
        (void)hipDeviceGetAttribute(&cus, hipDeviceAttributeMultiprocessorCount, dev);
        if (hipFuncSetAttribute((const void*)fwd_kernel, hipFuncAttributeMaxDynamicSharedMemorySize, LDS_BYTES) != hipSuccess) { fprintf(stderr, "kernel_launch: hipFuncSetAttribute failed\n"); grid = -1; return; }
        if (hipOccupancyMaxActiveBlocksPerMultiprocessor(&per_cu, (const void*)fwd_kernel, 512, LDS_BYTES) != hipSuccess || per_cu < 1) { fprintf(stderr, "kernel_launch: occupancy query gave %d\n", per_cu); per_cu = 1; }
        (void)hipGetLastError();
        grid = cus * per_cu;
        if (grid <= 0) grid = 256;
    }
    if (grid < 0) return;
    (void)hipMemsetAsync((char*)d_ws + WS_BAR, 0, 16384, stream);
    Args a{};
    for (int i = 0; i < 15; ++i) a.in[i] = (const float*)d_in[i];
    a.out = (float*)d_out; a.ws = (unsigned char*)d_ws;
#if N_LAUNCH_MODE == 1
    a.ph_lo = 0; a.ph_hi = NPHASE;
    void* args[] = {&a};
    hipError_t e = hipLaunchCooperativeKernel((const void*)fwd_kernel, dim3(grid), dim3(512), args, LDS_BYTES, stream);
    if (e != hipSuccess) fprintf(stderr, "cooperative launch failed: %s (grid %d)\n", hipGetErrorString(e), grid);
#else
    for (int ph = 0; ph < NPHASE; ++ph) {
        a.ph_lo = ph; a.ph_hi = ph + 1;
        hipLaunchKernelGGL(fwd_kernel, dim3(grid), dim3(512), LDS_BYTES, stream, a);
    }
#endif
}
```

```cpp
#include <hip/hip_runtime.h>
#include <hip/hip_cooperative_groups.h>
#include <cstdio>
#include <cstdint>
namespace cg = cooperative_groups;

#define LAS __attribute__((address_space(3)))
typedef unsigned short bf16_t;
typedef short bf16x8 __attribute__((ext_vector_type(8)));
typedef short s16x4 __attribute__((ext_vector_type(4)));
typedef float f32x2 __attribute__((ext_vector_type(2)));
typedef float f32x4 __attribute__((ext_vector_type(4)));
typedef float f32x16 __attribute__((ext_vector_type(16)));
typedef unsigned u32x2 __attribute__((ext_vector_type(2)));
typedef unsigned u32x4 __attribute__((ext_vector_type(4)));

#ifndef N_LAUNCH_MODE
#define N_LAUNCH_MODE 1
#endif

constexpr int DM = 1024, SEQ = 4096, NSEQ = 12, MTOK = NSEQ * SEQ, MPROMPT = 8 * SEQ;
constexpr int EVEN_IN = 2304, ODD_IN = 3072;
constexpr float EPS = 1e-6f;
constexpr float C2 = 0.125f * 1.4426950408889634f;
constexpr int NPHASE = 17;

constexpr size_t WS_WINE = 0;
constexpr size_t WS_WOUTE = WS_WINE + 2ull * 2304 * 1024 * 2;
constexpr size_t WS_WINO = WS_WOUTE + 2ull * 1024 * 1024 * 2;
constexpr size_t WS_WOUTO = WS_WINO + 2ull * 3072 * 1024 * 2;
constexpr size_t WS_POOLW = WS_WOUTO + 2ull * 1024 * 1024 * 2;
constexpr size_t WS_WSB = WS_POOLW + 2ull * 4 * 128 * 128 * 2;
constexpr size_t WS_ROPE = WS_WSB + 2ull * 8 * 128 * 128 * 2;
constexpr size_t WS_BAR = WS_ROPE + 8192;
constexpr size_t WS_SS = 32ull << 20;
constexpr size_t WS_SSV = WS_SS + (size_t)MTOK * 16 * 4;
constexpr size_t WS_XB = 40ull << 20;
constexpr size_t WS_P = WS_XB + (size_t)MTOK * 1024 * 2;
constexpr size_t WS_END = WS_P + (size_t)MTOK * 3072 * 2;
static_assert(WS_BAR + 16384 <= WS_SS && WS_SSV + (size_t)MTOK * 64 <= WS_XB, "ws map");

constexpr int LDS_BYTES = 159760;
constexpr int BARW_OFF = 159744;
constexpr int XL_OFF = 131072;
constexpr int ROPE_OFF = 139264;
constexpr int RST_OFF = 147456;

__device__ __forceinline__ unsigned cvt_pk_bf16(float lo, float hi) { unsigned r; asm volatile("v_cvt_pk_bf16_f32 %0, %1, %2" : "=v"(r) : "v"(lo), "v"(hi)); return r; }
__device__ __forceinline__ float bflo(unsigned w) { return __uint_as_float(w << 16); }
__device__ __forceinline__ float bfhi(unsigned w) { return __uint_as_float(w & 0xffff0000u); }
__device__ __forceinline__ float silu_f(float v) { return v * __builtin_amdgcn_rcpf(1.f + __builtin_amdgcn_exp2f(-1.4426950408889634f * v)); }
__device__ __forceinline__ float wave_sum(float v) {
#pragma unroll
    for (int o = 1; o < 64; o <<= 1) v += __shfl_xor(v, o);
    return v;
}
#define LDS_WAIT() asm volatile("s_waitcnt lgkmcnt(0)" ::: "memory")
__device__ __forceinline__ f32x2 gelu_pk(f32x2 v) {
    const f32x2 av = __builtin_elementwise_abs(v), d = av * 0.2316418882f + 1.0f;
    f32x2 t; t.x = __builtin_amdgcn_rcpf(d.x); t.y = __builtin_amdgcn_rcpf(d.y);
    f32x2 q = t * 0.5307027145f + (-0.7265760135f); q = q * t + 0.7107068705f; q = q * t + (-0.142248368f); q = q * t + 0.127414796f; q = q * t;
    const f32x2 s = (v * v) * (-0.72134752044f);
    f32x2 e; e.x = __builtin_amdgcn_exp2f(s.x); e.y = __builtin_amdgcn_exp2f(s.y);
    const f32x2 m = v * (q * e), r = v - m;
    f32x2 o; o.x = v.x < 0.f ? m.x : r.x; o.y = v.y < 0.f ? m.y : r.y; return o;
}
__device__ __forceinline__ f32x4 gelu4(f32x4 v) { f32x2 a = gelu_pk((f32x2){v[0], v[1]}), b = gelu_pk((f32x2){v[2], v[3]}); return (f32x4){a.x, a.y, b.x, b.y}; }
__device__ __forceinline__ f32x4 silu4(f32x4 v) { return (f32x4){silu_f(v[0]), silu_f(v[1]), silu_f(v[2]), silu_f(v[3])}; }

__device__ __forceinline__ u32x4 pack8(f32x4 a, f32x4 b) { u32x4 w; w.x = cvt_pk_bf16(a[0], a[1]); w.y = cvt_pk_bf16(a[2], a[3]); w.z = cvt_pk_bf16(b[0], b[1]); w.w = cvt_pk_bf16(b[2], b[3]); return w; }
__device__ __forceinline__ float sq4(f32x4 a) { return (a[0] * a[0] + a[1] * a[1]) + (a[2] * a[2] + a[3] * a[3]); }
__device__ __forceinline__ float fq_sum(float s) {
    const auto a = __builtin_amdgcn_permlane16_swap(__float_as_uint(s), __float_as_uint(s), false, false);
    const float t = __uint_as_float(a[0]) + __uint_as_float(a[1]);
    const auto b = __builtin_amdgcn_permlane32_swap(__float_as_uint(t), __float_as_uint(t), false, false);
    return __uint_as_float(b[0]) + __uint_as_float(b[1]);
}
__device__ __forceinline__ float xor32(float v, bool lo) {
    const auto a = __builtin_amdgcn_permlane32_swap(__float_as_uint(v), __float_as_uint(v), false, false);
    return __uint_as_float(lo ? a[1] : a[0]);
}
__device__ __forceinline__ float row_rstd(const float* ss, int row, int fq) {
    const f32x4 p = *(const f32x4*)(ss + (size_t)row * 16 + 4 * fq);
    const float s = fq_sum((p[0] + p[1]) + (p[2] + p[3]));
    return __builtin_amdgcn_rsqf(s * (1.0f / 1024.0f) + EPS);
}

__device__ __forceinline__ void store_rows64(LAS unsigned char* st, bf16_t* base, size_t pitch, u32x4 val, int fr, int fq, int lane) {
    *(LAS u32x4*)(st + fr * 80 + fq * 16) = val;
    const u32x4 t = *(const LAS u32x4*)(st + (lane >> 2) * 80 + (lane & 3) * 16);
    *(u32x4*)(base + (size_t)(lane >> 2) * pitch + (lane & 3) * 8) = t;
}
namespace pg8 {
constexpr int BM = 256, BK = 64, HALF = 128, HTB = HALF * BK * 2, STAGE_BYTES = 8 * HTB, NXCD = 8, WGM = 8;
__host__ __device__ __forceinline__ int lds_byte(int r, int c) { const int st = (r >> 4) * 2 + (c >> 5), rr = r & 15, cc = c & 31, ob = rr * 64 + cc * 2; return st * 1024 + (ob ^ (((ob >> 9) & 1) << 5)); }
__host__ __device__ __forceinline__ void stage_rc(int b, int& R, int& C) { const int st = b / 1024, sb = b % 1024, swz = sb ^ (((sb >> 9) & 1) << 5); R = (st >> 1) * 16 + swz / 64; C = (st & 1) * 32 + (swz % 64) / 2; }
__host__ __device__ __forceinline__ int perm32(int rho) { const int n = rho >> 4, i = rho & 15; return 8 * (i >> 2) + 4 * n + (i & 3); }

struct Unit { int pm, pn; };
struct Gemm { const bf16_t* A; const bf16_t* Bt; int M, N, K, lda, xtra; };

struct StaticOrder {
    int nM, nN, nwg, G, c;
    __host__ __device__ void init(int M, int N, int G_, int c_) { nM = M / BM; nN = N / BM; nwg = nM * nN; G = G_; c = c_; }
    __host__ __device__ bool next(int i, Unit& u) const {
        const long L = (long)i * G + c; if (L >= nwg) return false;
        int wgid = (int)L; { const int q = nwg / NXCD, r = nwg % NXCD, xcd = wgid % NXCD, off = wgid / NXCD; wgid = (xcd < r ? xcd * (q + 1) : r * (q + 1) + (xcd - r) * q) + off; }
        const int nig = WGM * nN, gid = wgid / nig, fm = gid * WGM, gsz = (nM - fm) < WGM ? (nM - fm) : WGM;
        u.pm = fm + ((wgid % nig) % gsz); u.pn = (wgid % nig) / gsz; return true;
    }
};

template <class Epi>
__device__ __forceinline__ void gemm_phase(LAS unsigned char* lds, const Gemm g, const StaticOrder& S, const Epi& E, const int tid) {
    const int wid = __builtin_amdgcn_readfirstlane(tid >> 6), lane = tid & 63, wr = wid >> 2, wc = wid & 3, fr = lane & 15, fq = lane >> 4;
    const int K = g.K, nt = K / BK, lda = g.lda;
    unsigned voffA[2], voffB[2];
#pragma unroll
    for (int i = 0; i < 2; ++i) { int R, C; stage_rc(tid * 16 + i * 8192, R, C); const int Rb = (R & ~31) + perm32(R & 31);
        voffA[i] = (unsigned)(R * lda + C) * 2u; voffB[i] = (unsigned)(Rb * K + C) * 2u; }
    const size_t kstep = (size_t)(BK * 2);
    const size_t hstepA = (size_t)HALF * lda * 2, tstepA = 2 * hstepA;
    const size_t hstepB = (size_t)HALF * K * 2, tstepB = 2 * hstepB;
    const size_t xtra = (size_t)g.xtra;
    const unsigned ldsw = (unsigned)wid * 1024u;
    const int aoff = lds_byte(wr * 64 + fr, fq * 8), boff = lds_byte(wc * 32 + fr, fq * 8);
#define PG8_SA(b, h) (((b) * 2 + (h)) * HTB)
#define PG8_SB(b, h) ((4 + (b) * 2 + (h)) * HTB)
#define PG8_STAGE(bufoff, gbase, voff) do { _Pragma("unroll") for (int _i = 0; _i < 2; ++_i) \
        __builtin_amdgcn_global_load_lds((const unsigned*)((const char*)(gbase) + (voff)[_i]), (LAS unsigned*)(lds + (bufoff) + ldsw + _i * 8192), 16, 0, 0); } while (0)
#define PG8_LDA(dst, b, h) do { _Pragma("unroll") for (int m = 0; m < 4; ++m) _Pragma("unroll") for (int k = 0; k < 2; ++k) dst[m][k] = *(const LAS bf16x8*)(lds + PG8_SA(b, h) + aoff + m * 2048 + k * 1024); } while (0)
#define PG8_LDB(dst, b, h) do { _Pragma("unroll") for (int n = 0; n < 2; ++n) _Pragma("unroll") for (int k = 0; k < 2; ++k) dst[n][k] = *(const LAS bf16x8*)(lds + PG8_SB(b, h) + boff + n * 2048 + k * 1024); } while (0)
#define PG8_MMA(ai, bj, At, Bt) do { __builtin_amdgcn_s_setprio(1); _Pragma("unroll") for (int m = 0; m < 4; ++m) _Pragma("unroll") for (int n = 0; n < 2; ++n) _Pragma("unroll") for (int k = 0; k < 2; ++k) \
        acc[ai][bj][m][n] = __builtin_amdgcn_mfma_f32_16x16x32_bf16(Bt[n][k], At[m][k], acc[ai][bj][m][n], 0, 0, 0); __builtin_amdgcn_s_setprio(0); } while (0)
#define PG8_WAIT_V(n) asm volatile("s_waitcnt vmcnt(" #n ")" ::: "memory")
#define PG8_WAIT_L(n) asm volatile("s_waitcnt lgkmcnt(" #n ")" ::: "memory")
#define PG8_BAR __builtin_amdgcn_s_barrier()
#define PG8_SCHED __builtin_amdgcn_sched_barrier(0)
    Unit cur, nxt; int ui = 0;
    if (!S.next(0, cur)) return;
    f32x4 acc[2][2][4][2];
#pragma unroll
    for (int a = 0; a < 2; ++a)
#pragma unroll
        for (int b = 0; b < 2; ++b)
#pragma unroll
            for (int m = 0; m < 4; ++m)
#pragma unroll
                for (int n = 0; n < 2; ++n) acc[a][b][m][n] = (f32x4){0.f, 0.f, 0.f, 0.f};
    bf16x8 At[4][2], B0[2][2], B1[2][2];
    const char* cA = (const char*)g.A + (size_t)cur.pm * tstepA; const char* cB = (const char*)g.Bt + (size_t)cur.pn * tstepB;
    f32x4 pf[2];
    E.pre(cur.pm, tid, pf); E.post(0, tid, pf);
    PG8_STAGE(PG8_SB(0, 0), cB, voffB); PG8_STAGE(PG8_SB(0, 1), cB + hstepB, voffB); PG8_STAGE(PG8_SA(0, 0), cA, voffA); PG8_STAGE(PG8_SA(0, 1), cA + hstepA, voffA);
    if (wr == 1) PG8_BAR;
    PG8_WAIT_V(2); PG8_BAR;
    PG8_STAGE(PG8_SB(1, 0), cB + kstep, voffB); PG8_STAGE(PG8_SA(1, 0), cA + kstep, voffA); PG8_STAGE(PG8_SB(1, 1), cB + hstepB + kstep, voffB);
    PG8_WAIT_V(6); PG8_BAR;
    for (;;) {
        const bool has_next = S.next(ui + 1, nxt);
        const char* nA = has_next ? (const char*)g.A + (size_t)nxt.pm * tstepA : cA; const char* nB = has_next ? (const char*)g.Bt + (size_t)nxt.pn * tstepB : cB;
        for (int t = 0; t < nt; t += 2) {
            const bool last = (t == nt - 2);
            const char* a1 = cA + (size_t)(t + 1) * kstep + ((t + 1) >= 8 ? xtra : 0);
            const char* a2 = last ? nA : cA + (size_t)(t + 2) * kstep + ((t + 2) >= 8 ? xtra : 0); const char* b2 = last ? nB : cB + (size_t)(t + 2) * kstep;
            const char* a3 = a2 + kstep; const char* b3 = b2 + kstep;
            PG8_LDB(B0, 0, 0); PG8_LDB(B1, 0, 1); PG8_SCHED; PG8_LDA(At, 0, 0); PG8_STAGE(PG8_SA(1, 1), a1 + hstepA, voffA);
            PG8_WAIT_V(8); PG8_WAIT_L(0); PG8_BAR; PG8_MMA(0, 0, At, B0); PG8_MMA(0, 1, At, B1); PG8_BAR; PG8_SCHED;
            PG8_LDA(At, 0, 1); PG8_STAGE(PG8_SB(0, 0), b2, voffB); PG8_STAGE(PG8_SB(0, 1), b2 + hstepB, voffB); PG8_STAGE(PG8_SA(0, 0), a2, voffA);
            PG8_WAIT_V(8); PG8_WAIT_L(0); PG8_BAR; PG8_MMA(1, 0, At, B0); PG8_MMA(1, 1, At, B1); PG8_BAR; PG8_SCHED;
            PG8_LDB(B0, 1, 0); PG8_LDB(B1, 1, 1); PG8_SCHED; PG8_LDA(At, 1, 0); PG8_STAGE(PG8_SA(0, 1), a2 + hstepA, voffA);
            PG8_WAIT_V(8); PG8_WAIT_L(0); PG8_BAR; PG8_MMA(0, 0, At, B0); PG8_MMA(0, 1, At, B1); PG8_BAR; PG8_SCHED;
            PG8_LDA(At, 1, 1); PG8_STAGE(PG8_SB(1, 0), b3, voffB); PG8_STAGE(PG8_SB(1, 1), b3 + hstepB, voffB); PG8_STAGE(PG8_SA(1, 0), a3, voffA);
            PG8_WAIT_V(8); PG8_WAIT_L(0); PG8_BAR; PG8_MMA(1, 0, At, B0); PG8_MMA(1, 1, At, B1); PG8_BAR; PG8_SCHED;
        }
        if (wr == 0) PG8_BAR;
        if (has_next) E.pre(nxt.pm, tid, pf);
        E(acc, cur, wr, wc, fr, fq, ui & 1);
        if (has_next) E.post((ui + 1) & 1, tid, pf);
        if (!has_next) break;
#pragma unroll
        for (int a = 0; a < 2; ++a)
#pragma unroll
            for (int b = 0; b < 2; ++b)
#pragma unroll
                for (int m = 0; m < 4; ++m)
#pragma unroll
                    for (int n = 0; n < 2; ++n) acc[a][b][m][n] = (f32x4){0.f, 0.f, 0.f, 0.f};
        cur = nxt; cA = nA; cB = nB; ++ui;
        if (wr == 1) PG8_BAR;
    }
    PG8_WAIT_V(0);
    PG8_BAR;
#undef PG8_SA
#undef PG8_SB
#undef PG8_STAGE
#undef PG8_LDA
#undef PG8_LDB
#undef PG8_MMA
#undef PG8_WAIT_V
#undef PG8_WAIT_L
#undef PG8_BAR
#undef PG8_SCHED
}

struct EpiEvenIn {
    bf16_t* P; const float* ss; LAS float* rst;
    __device__ __forceinline__ void pre(int pm, int tid, f32x4 (&r)[2]) const {
        const float* p = ss + ((size_t)pm * BM + (tid >> 1)) * 16 + 8 * (tid & 1);
        r[0] = *(const f32x4*)p; r[1] = *(const f32x4*)(p + 4);
    }
    __device__ __forceinline__ void post(int slot, int tid, const f32x4 (&r)[2]) const {
        const f32x4 t = r[0] + r[1]; float s = (t[0] + t[1]) + (t[2] + t[3]);
        s += __shfl_xor(s, 1);
        if ((tid & 1) == 0) rst[slot * 256 + (tid >> 1)] = __builtin_amdgcn_rsqf(s * (1.0f / 1024.0f) + EPS);
    }
    __device__ __forceinline__ void operator()(const f32x4 (&acc)[2][2][4][2], const Unit& u, int wr, int wc, int fr_, int fq_, int slot) const {
        int fr = fr_, fq = fq_; asm volatile("" : "+v"(fr), "+v"(fq));
        const int pn = u.pn;
        const int col0 = pn * BM + wc * 32 + 8 * fq;
        float rs[2][4];
#pragma unroll
        for (int ai = 0; ai < 2; ++ai)
#pragma unroll
            for (int m = 0; m < 4; ++m) rs[ai][m] = rst[slot * 256 + ai * HALF + wr * 64 + m * 16 + fr];
#pragma unroll
        for (int ai = 0; ai < 2; ++ai)
#pragma unroll
            for (int m = 0; m < 4; ++m) {
                bf16_t* rowp = P + (size_t)(u.pm * BM + ai * HALF + wr * 64 + m * 16 + fr) * EVEN_IN + col0;
#pragma unroll
                for (int bj = 0; bj < 2; ++bj) {
                    f32x4 v0 = acc[ai][bj][m][0] * rs[ai][m], v1 = acc[ai][bj][m][1] * rs[ai][m];
                    *(u32x4*)(rowp + bj * HALF) = pack8(v0, v1);
                }
                asm volatile("" ::: "memory");
            }
    }
};

struct EpiOddIn {
    bf16_t* P; const float* ss; float* ssv; LAS float* rst;
    __device__ __forceinline__ void pre(int pm, int tid, f32x4 (&r)[2]) const {
        const float* p = ss + ((size_t)pm * BM + (tid >> 1)) * 16 + 8 * (tid & 1);
        r[0] = *(const f32x4*)p; r[1] = *(const f32x4*)(p + 4);
    }
    __device__ __forceinline__ void post(int slot, int tid, const f32x4 (&r)[2]) const {
        const f32x4 t = r[0] + r[1]; float s = (t[0] + t[1]) + (t[2] + t[3]);
        s += __shfl_xor(s, 1);
        if ((tid & 1) == 0) rst[slot * 256 + (tid >> 1)] = __builtin_amdgcn_rsqf(s * (1.0f / 1024.0f) + EPS);
    }
    __device__ __forceinline__ void operator()(const f32x4 (&acc)[2][2][4][2], const Unit& u, int wr, int wc, int fr_, int fq_, int slot) const {
        int fr = fr_, fq = fq_; asm volatile("" : "+v"(fr), "+v"(fq));
        const int pn = u.pn, col0 = pn * BM + wc * 32 + 8 * fq;
        float rs[2][4];
#pragma unroll
        for (int ai = 0; ai < 2; ++ai)
#pragma unroll
            for (int m = 0; m < 4; ++m) rs[ai][m] = rst[slot * 256 + ai * HALF + wr * 64 + m * 16 + fr];
#pragma unroll
        for (int ai = 0; ai < 2; ++ai)
#pragma unroll
            for (int m = 0; m < 4; ++m) {
                const int row = u.pm * BM + ai * HALF + wr * 64 + m * 16 + fr;
                const float r = rs[ai][m];
                bf16_t* rowp = P + (size_t)row * ODD_IN + col0;
                float sq = 0.f;
#pragma unroll
                for (int bj = 0; bj < 2; ++bj) {
                    f32x4 v0 = acc[ai][bj][m][0] * r, v1 = acc[ai][bj][m][1] * r;
                    if (pn >= 4 && pn < 8) { v0 = gelu4(v0); v1 = gelu4(v1); sq += sq4(v0) + sq4(v1); }
                    *(u32x4*)(rowp + bj * HALF) = pack8(v0, v1);
                }
                if (pn >= 4 && pn < 8) { sq = fq_sum(sq); if (fq == 0) ssv[(size_t)row * 16 + (pn - 4) * 4 + wc] = sq; }
                asm volatile("" ::: "memory");
            }
    }
};

struct EpiOut {
    float* X; const float* R0; const float* R1; bf16_t* XB; float* ss; bool dry; bool lastl;
    __device__ __forceinline__ void pre(int, int, f32x4 (&)[2]) const {}
    __device__ __forceinline__ void post(int, int, const f32x4 (&)[2]) const {}
    __device__ __forceinline__ void load2(f32x4 (&xv)[2][2][2], const float* rb, int b) const {
#pragma unroll
        for (int mm = 0; mm < 2; ++mm) {
            const float* xp = rb + (size_t)((b >> 1) * HALF + (2 * (b & 1) + mm) * 16) * DM;
#pragma unroll
            for (int bj = 0; bj < 2; ++bj) { xv[mm][bj][0] = *(const f32x4*)(xp + bj * HALF); xv[mm][bj][1] = *(const f32x4*)(xp + bj * HALF + 4); }
        }
    }
    __device__ __forceinline__ void operator()(const f32x4 (&acc)[2][2][4][2], const Unit& u, int wr, int wc, int fr_, int fq_, int slot) const {
        int fr = fr_, fq = fq_; asm volatile("" : "+v"(fr), "+v"(fq));
        const int pn = u.pn, col0 = pn * BM + wc * 32 + 8 * fq;
        const float* rb = ((u.pm * BM < MPROMPT) ? R0 : R1) + (size_t)(u.pm * BM + wr * 64 + fr) * DM + col0;
        f32x4 xa[2][2][2], xb2[2][2][2];
        load2(xa, rb, 0);
#pragma unroll
        for (int b = 0; b < 4; ++b) {
            if (b + 1 < 4) { if (b & 1) load2(xa, rb, b + 1); else load2(xb2, rb, b + 1); }
            const int ai = b >> 1;
#pragma unroll
            for (int mm = 0; mm < 2; ++mm) {
                const int m = 2 * (b & 1) + mm;
                const int row = u.pm * BM + ai * HALF + wr * 64 + m * 16 + fr;
                float* xp = X + (size_t)row * DM + col0; bf16_t* bp = XB + (size_t)row * DM + col0;
                float sq = 0.f;
#pragma unroll
                for (int bj = 0; bj < 2; ++bj) {
                    const f32x4 x0 = ((b & 1) ? xb2[mm][bj][0] : xa[mm][bj][0]) + acc[ai][bj][m][0], x1 = ((b & 1) ? xb2[mm][bj][1] : xa[mm][bj][1]) + acc[ai][bj][m][1];
                    if (!dry) { *(f32x4*)(xp + bj * HALF) = x0; *(f32x4*)(xp + bj * HALF + 4) = x1;
                    if (!lastl) *(u32x4*)(bp + bj * HALF) = pack8(x0, x1); }
                    sq += sq4(x0) + sq4(x1);
                }
                if (!lastl) { sq = fq_sum(sq); if (fq == 0 && !dry) ss[(size_t)row * 16 + pn * 4 + wc] = sq; }
            }
        }
    }
};
}

__device__ __forceinline__ void p0_transpose_item(const float* W, int K, int N, bf16_t* WT, const float* gk, LAS float* scr, int item, int lane) {
    const int nblk = N / 32, kb = item / nblk, nb = item % nblk, k0 = 64 * kb, n0 = 32 * nb;
#pragma unroll
    for (int i = 0; i < 8; ++i) {
        const int kk = 8 * i + (lane >> 3); f32x4 v = *(const f32x4*)(W + (size_t)(k0 + kk) * N + n0 + 4 * (lane & 7));
        if (gk) v = v * gk[k0 + kk];
        LAS float* d = scr + kk * 33 + 4 * (lane & 7); d[0] = v[0]; d[1] = v[1]; d[2] = v[2]; d[3] = v[3];
    }
    LDS_WAIT(); asm volatile("" ::: "memory");
    const int c = lane & 7;
#pragma unroll
    for (int j = 0; j < 4; ++j) { const int n = (lane >> 3) + 8 * j; const LAS float* s = scr + (8 * c) * 33 + n;
        u32x4 o; o.x = cvt_pk_bf16(s[0 * 33], s[1 * 33]); o.y = cvt_pk_bf16(s[2 * 33], s[3 * 33]); o.z = cvt_pk_bf16(s[4 * 33], s[5 * 33]); o.w = cvt_pk_bf16(s[6 * 33], s[7 * 33]);
        *(u32x4*)(WT + (size_t)(n0 + n) * K + k0 + 8 * c) = o; }
    LDS_WAIT(); asm volatile("" ::: "memory");
}

struct Args { const float* in[15]; float* out; unsigned char* ws; int ph_lo, ph_hi; };

__device__ __forceinline__ void prologue(const Args& a, LAS unsigned char* lds, int tid, int lane, int wid) {
    unsigned char* ws = a.ws;
    const int G = gridDim.x, gw = blockIdx.x * 8 + wid, NGW = G * 8;
    LAS float* scr = (LAS float*)(lds + wid * 16384);
    constexpr int I_INE = 16 * 72, I_OUT = 16 * 32, I_INO = 16 * 96, I_POOL = 2 * 4;
    constexpr int NITEMS = 2 * (I_INE + I_OUT + I_INO + I_OUT) + 8 * I_POOL;
    for (int it = gw; it < NITEMS; it += NGW) {
        int r = it;
        if (r < 2 * I_INE) { const int j = r / I_INE; p0_transpose_item(a.in[3] + (size_t)j * 1024 * 2304, 1024, 2304, (bf16_t*)(ws + WS_WINE) + (size_t)j * 2304 * 1024, a.in[2] + j * 1024, scr, r % I_INE, lane); continue; } r -= 2 * I_INE;
        if (r < 2 * I_OUT) { const int j = r / I_OUT; p0_transpose_item(a.in[8] + (size_t)j * 1024 * 1024, 1024, 1024, (bf16_t*)(ws + WS_WOUTE) + (size_t)j * 1024 * 1024, nullptr, scr, r % I_OUT, lane); continue; } r -= 2 * I_OUT;
        if (r < 2 * I_INO) { const int j = r / I_INO; p0_transpose_item(a.in[10] + (size_t)j * 1024 * 3072, 1024, 3072, (bf16_t*)(ws + WS_WINO) + (size_t)j * 3072 * 1024, a.in[9] + j * 1024, scr, r % I_INO, lane); continue; } r -= 2 * I_INO;
        if (r < 2 * I_OUT) { const int j = r / I_OUT; p0_transpose_item(a.in[14] + (size_t)j * 1024 * 1024, 1024, 1024, (bf16_t*)(ws + WS_WOUTO) + (size_t)j * 1024 * 1024, nullptr, scr, r % I_OUT, lane); continue; } r -= 2 * I_OUT;
        { const int mt = r / I_POOL; p0_transpose_item(a.in[4] + (size_t)mt * 128 * 128, 128, 128, (bf16_t*)(ws + WS_POOLW) + (size_t)mt * 128 * 128, nullptr, scr, r % I_POOL, lane); }
    }
    { const float* wsf = a.in[12]; bf16_t* dst = (bf16_t*)(ws + WS_WSB);
      for (int i = (blockIdx.x * 512 + tid) * 4; i < 2 * 8 * 128 * 128; i += G * 512 * 4) { const f32x4 v = *(const f32x4*)(wsf + i); u32x2 o; o.x = cvt_pk_bf16(v[0], v[1]); o.y = cvt_pk_bf16(v[2], v[3]); *(u32x2*)(dst + i) = o; } }
    { float* rope = (float*)(ws + WS_ROPE);
      for (int i = blockIdx.x * 512 + tid; i < 1024; i += G * 512) { const int idx = i >> 4, f = i & 15; const float inv = 1.0f / powf(10000.0f, (float)f / 16.0f); const float ang = (float)idx * inv; rope[i] = cosf(ang); rope[1024 + i] = sinf(ang); } }
    { const float* xp = a.in[0]; const float* xs = a.in[1]; float* ss = (float*)(ws + WS_SS); bf16_t* xb = (bf16_t*)(ws + WS_XB);
      for (int m = gw; m < MTOK; m += NGW) {
          const float* src = (m < MPROMPT) ? xp + (size_t)m * DM : xs + (size_t)(m - MPROMPT) * DM;
          f32x4 v[4]; float s = 0.f;
#pragma unroll
          for (int j = 0; j < 4; ++j) { v[j] = *(const f32x4*)(src + (lane + 64 * j) * 4); s += sq4(v[j]); }
          s = wave_sum(s);
#pragma unroll
          for (int j = 0; j < 4; ++j) { u32x2 o; o.x = cvt_pk_bf16(v[j][0], v[j][1]); o.y = cvt_pk_bf16(v[j][2], v[j][3]); *(u32x2*)(xb + (size_t)m * DM + (lane + 64 * j) * 4) = o; }
          if (lane < 16) ss[(size_t)m * 16 + lane] = (lane == 0) ? s : 0.f;
      } }
}

__device__ __forceinline__ void kprep_item(bf16_t* P, const float* kg, const float* rope, int idx, const u32x4 w) {
    const int e8 = idx & 7, hk = (idx >> 3) & 1, row = idx >> 4;
    float x[8] = {bflo(w.x), bfhi(w.x), bflo(w.y), bfhi(w.y), bflo(w.z), bfhi(w.z), bflo(w.w), bfhi(w.w)};
    float ssq = 0.f;
#pragma unroll
    for (int e = 0; e < 8; ++e) ssq += x[e] * x[e];
    ssq += __shfl_xor(ssq, 1); ssq += __shfl_xor(ssq, 2); ssq += __shfl_xor(ssq, 4);
    const float rh = __builtin_amdgcn_rsqf(ssq * (1.0f / 64.0f) + EPS);
    const int t = row & (SEQ - 1), ir = (e8 < 4) ? (t >> 6) : (t & 63), f0 = 8 * (e8 & 1);
    const f32x4 g0 = *(const f32x4*)(kg + e8 * 8), g1 = *(const f32x4*)(kg + e8 * 8 + 4);
    const f32x4 c0 = *(const f32x4*)(rope + ir * 16 + f0), c1 = *(const f32x4*)(rope + ir * 16 + f0 + 4);
    const f32x4 s0 = *(const f32x4*)(rope + 1024 + ir * 16 + f0), s1 = *(const f32x4*)(rope + 1024 + ir * 16 + f0 + 4);
    const float sgn = (e8 & 2) ? 1.0f : -1.0f;
    float o[8];
#pragma unroll
    for (int e = 0; e < 8; ++e) {
        const float y = x[e] * rh * (e < 4 ? g0[e & 3] : g1[e & 3]);
        const float other = __shfl_xor(y, 2);
        o[e] = y * (e < 4 ? c0[e & 3] : c1[e & 3]) + sgn * other * (e < 4 ? s0[e & 3] : s1[e & 3]);
    }
    u32x4 r; r.x = cvt_pk_bf16(o[0], o[1]); r.y = cvt_pk_bf16(o[2], o[3]); r.z = cvt_pk_bf16(o[4], o[5]); r.w = cvt_pk_bf16(o[6], o[7]);
    *(u32x4*)(P + (size_t)row * EVEN_IN + 1536 + hk * 64 + e8 * 8) = r;
}
__device__ __forceinline__ void kprep_phase(bf16_t* P, const float* kg, const float* rope, int tid, int bx, int G) {
    const int stride = G * 512;
    for (int base = bx * 512 + tid; base < MTOK * 16; base += 3 * stride) {
        u32x4 w[3];
#pragma unroll
        for (int q = 0; q < 3; ++q) { const int idx = base + q * stride; if (idx < MTOK * 16) w[q] = *(const u32x4*)(P + (size_t)(idx >> 4) * EVEN_IN + 1536 + ((idx >> 3) & 1) * 64 + (idx & 7) * 8); }
#pragma unroll
        for (int q = 0; q < 3; ++q) { const int idx = base + q * stride; if (idx < MTOK * 16) kprep_item(P, kg, rope, idx, w[q]); }
    }
}

#define MFMA32(a, b, c) __builtin_amdgcn_mfma_f32_32x32x16_bf16(a, b, c, 0, 0, 0)
#define MFMA16(a, b, c) __builtin_amdgcn_mfma_f32_16x16x32_bf16(a, b, c, 0, 0, 0)
__device__ __forceinline__ s16x4 vtr(const LAS unsigned char* p) { return __builtin_bit_cast(s16x4, __builtin_amdgcn_ds_read_tr16_b64_v4i16((LAS s16x4*)p)); }
__device__ __forceinline__ float max3f(float a, float b, float c) { return __builtin_fmaxf(__builtin_fmaxf(a, b), c); }

#define ABAR() asm volatile("s_waitcnt lgkmcnt(0)\n\ts_barrier" ::: "memory")
#define SGB(mask, n) __builtin_amdgcn_sched_group_barrier(mask, n, 0)
typedef __bf16 bf16v2 __attribute__((ext_vector_type(2)));
__device__ __forceinline__ unsigned cvtpk(float a, float b) { const bf16v2 r = __builtin_convertvector((f32x2){a, b}, bf16v2); return __builtin_bit_cast(unsigned, r); }
__device__ __forceinline__ float pairmax(float m) { auto rr = __builtin_amdgcn_permlane32_swap(__float_as_uint(m), __float_as_uint(m), false, false); return __builtin_fmaxf(__uint_as_float(rr[0]), __uint_as_float(rr[1])); }
__device__ __forceinline__ float rowmax32(const f32x16& p0, const f32x16& p1) {
    float a = max3f(p0[0], p0[1], p1[0]), b = max3f(p0[2], p0[3], p1[1]); a = max3f(a, p1[2], p1[3]);
#pragma unroll
    for (int r = 4; r < 16; r += 4) { a = max3f(a, p0[r], p0[r + 1]); b = max3f(b, p0[r + 2], p0[r + 3]); a = max3f(a, p1[r], p1[r + 1]); b = max3f(b, p1[r + 2], p1[r + 3]); }
    return pairmax(__builtin_fmaxf(a, b));
}
#define SBAR() __builtin_amdgcn_sched_barrier(0)
#define PIN(x) asm volatile("" : "+v"(x))
#define VCHUNK(PC, KB, R) do { \
        float e0_ = __builtin_amdgcn_exp2f(PC[(R)]), e1_ = __builtin_amdgcn_exp2f(PC[(R) + 1]), e2_ = __builtin_amdgcn_exp2f(PC[(R) + 2]), e3_ = __builtin_amdgcn_exp2f(PC[(R) + 3]); \
        s0 += e0_; s1 += e1_; s2 += e2_; s3 += e3_; pw[KB][(R) / 2] = cvtpk(e0_, e1_); pw[KB][(R) / 2 + 1] = cvtpk(e2_, e3_); \
        PIN(pw[KB][(R) / 2]); PIN(pw[KB][(R) / 2 + 1]); PIN(s0); PIN(s1); PIN(s2); PIN(s3); } while (0)
#define VTR4(J) do { const LAS unsigned char* vb_ = vc + (J) * 1024; va0 = vtr(vb_); va1 = vtr(vb_ + 512); vb0 = vtr(vb_ + 4096); vb1 = vtr(vb_ + 4096 + 512); } while (0)
#define PVJ(J) do { const u32x4 pbw_ = {pw[(J) >> 1][4 * ((J) & 1)], pw[(J) >> 1][4 * ((J) & 1) + 1], pw[(J) >> 1][4 * ((J) & 1) + 2], pw[(J) >> 1][4 * ((J) & 1) + 3]}; \
        const bf16x8 pb_ = __builtin_bit_cast(bf16x8, pbw_); \
        const bf16x8 fa_ = {va0[0], va0[1], va0[2], va0[3], va1[0], va1[1], va1[2], va1[3]}; const bf16x8 fb_ = {vb0[0], vb0[1], vb0[2], vb0[3], vb1[0], vb1[1], vb1[2], vb1[3]}; \
        o0 = MFMA32(fa_, pb_, o0); o1 = MFMA32(fb_, pb_, o1); } while (0)
#define ASTEP(T, PC0, PC1, PN0, PN1, KRO, VRO, KRN, VRN) do { \
        const int t_ = (T); \
        if (t_ + 3 < NT) KRN = *(const u32x4*)(ksrc + (size_t)(t_ + 3) * 64 * EVEN_IN); \
        if (t_ + 2 < NT) VRN = *(const u32x4*)(vsrc + (size_t)(t_ + 2) * 64 * EVEN_IN); \
        const LAS unsigned char* kn = lds + ((t_ + 1) & 1) * 8192 + koff; \
        const LAS unsigned char* vc = lds + (t_ & 1) * 8192 + voff; \
        bf16x8 kf[8]; \
        _Pragma("unroll") for (int d0 = 0; d0 < 4; ++d0) { kf[2 * d0] = *(const LAS bf16x8*)(kn + d0 * 2048); kf[2 * d0 + 1] = *(const LAS bf16x8*)(kn + d0 * 2048 + 512); } \
        unsigned pw[2][8]; float s0 = 0.f, s1 = 0.f, s2 = 0.f, s3 = 0.f; s16x4 va0, va1, vb0, vb1; \
        SBAR(); \
        VCHUNK(PC0, 0, 0); VCHUNK(PC1, 1, 0); SBAR(); \
        PN0 = MFMA32(kf[0], qf[0], negm); VCHUNK(PC0, 0, 4); SBAR(); \
        PN1 = MFMA32(kf[1], qf[0], negm); VCHUNK(PC1, 1, 4); SBAR(); \
        PN0 = MFMA32(kf[2], qf[1], PN0); VCHUNK(PC0, 0, 8); SBAR(); \
        PN1 = MFMA32(kf[3], qf[1], PN1); VCHUNK(PC1, 1, 8); SBAR(); \
        PN0 = MFMA32(kf[4], qf[2], PN0); VCHUNK(PC0, 0, 12); SBAR(); \
        PN1 = MFMA32(kf[5], qf[2], PN1); VCHUNK(PC1, 1, 12); SBAR(); \
        PN0 = MFMA32(kf[6], qf[3], PN0); VTR4(0); lsum += (s0 + s1) + (s2 + s3); SBAR(); \
        PN1 = MFMA32(kf[7], qf[3], PN1); SBAR(); \
        PVJ(0); VTR4(1); \
        float ma_ = max3f(PN0[0], PN0[1], PN0[2]); ma_ = max3f(ma_, PN0[3], PN0[4]); ma_ = max3f(ma_, PN0[5], PN0[6]); ma_ = max3f(ma_, PN0[7], PN0[8]); PIN(ma_); SBAR(); \
        PVJ(1); VTR4(2); \
        ma_ = max3f(ma_, PN0[9], PN0[10]); ma_ = max3f(ma_, PN0[11], PN0[12]); ma_ = max3f(ma_, PN0[13], PN0[14]); ma_ = max3f(ma_, PN0[15], PN1[0]); PIN(ma_); SBAR(); \
        PVJ(2); VTR4(3); \
        float mb_ = max3f(PN1[1], PN1[2], PN1[3]); mb_ = max3f(mb_, PN1[4], PN1[5]); mb_ = max3f(mb_, PN1[6], PN1[7]); mb_ = max3f(mb_, PN1[8], PN1[9]); PIN(mb_); SBAR(); \
        PVJ(3); \
        mb_ = max3f(mb_, PN1[10], PN1[11]); mb_ = max3f(mb_, PN1[12], PN1[13]); mb_ = max3f(mb_, PN1[14], PN1[15]); \
        const float mt_ = pairmax(__builtin_fmaxf(ma_, mb_)); \
        SBAR(); \
        if (t_ + 2 < NT) *(LAS u32x4*)(lds + (t_ & 1) * 8192 + kdst) = KRO; \
        if (t_ + 1 < NT) *(LAS u32x4*)(lds + ((t_ + 1) & 1) * 8192 + vdst) = VRO; \
        if (__builtin_amdgcn_ballot_w64(mt_ > THR) != 0ull) { \
            const float d_ = __builtin_fmaxf(mt_, 0.f), alpha_ = __builtin_amdgcn_exp2f(-d_); \
            mref += d_; lsum *= alpha_; \
            _Pragma("unroll") for (int r = 0; r < 16; ++r) { o0[r] *= alpha_; o1[r] *= alpha_; PN0[r] -= d_; PN1[r] -= d_; negm[r] = -mref; } \
        } \
        ABAR(); } while (0)
__device__ __forceinline__ void attn_unit(LAS unsigned char* lds, bf16_t* P, const float* qgain, const float* rope, int s, int h, int qb, int lane, int wid, bool dry) {
    const int r32 = lane & 31, hi = lane >> 5, kvh = h >> 2;
    const size_t rowbase = (size_t)s * SEQ;
    const bf16_t* ksrc = P + (rowbase + lane) * EVEN_IN + 1536 + kvh * 64 + wid * 8;
    const bf16_t* vsrc = P + (rowbase + 16 * (wid & 3) + (lane >> 2)) * EVEN_IN + 1664 + kvh * 64 + (wid >> 2) * 32 + (lane & 3) * 8;
    const int kdst = wid * 1024 + lane * 16;
    const int vdst = 16384 + (wid >> 2) * 4096 + (16 * (wid & 3) + (lane >> 2)) * 64 + (lane & 3) * 16;
    const size_t qrow = rowbase + (size_t)qb * 256 + wid * 32 + r32;
    const bf16_t* qg = P + qrow * EVEN_IN + 1024 + h * 64 + hi * 8;
    u32x4 krA = *(const u32x4*)ksrc, vrA = *(const u32x4*)vsrc;
    u32x4 krB = *(const u32x4*)(ksrc + (size_t)64 * EVEN_IN), vrB;
    bf16x8 qf[4];
    {
        float y[4][8]; float ssq = 0.f;
#pragma unroll
        for (int d0 = 0; d0 < 4; ++d0) { const u32x4 w = *(const u32x4*)(qg + d0 * 16);
            y[d0][0] = bflo(w.x); y[d0][1] = bfhi(w.x); y[d0][2] = bflo(w.y); y[d0][3] = bfhi(w.y); y[d0][4] = bflo(w.z); y[d0][5] = bfhi(w.z); y[d0][6] = bflo(w.w); y[d0][7] = bfhi(w.w);
#pragma unroll
            for (int e = 0; e < 8; ++e) ssq += y[d0][e] * y[d0][e]; }
        { const auto rr = __builtin_amdgcn_permlane32_swap(__float_as_uint(ssq), __float_as_uint(ssq), false, false); ssq = __uint_as_float(rr[0]) + __uint_as_float(rr[1]); }
        const float rh = __builtin_amdgcn_rsqf(ssq * (1.0f / 64.0f) + EPS) * C2;
        const int tq = qb * 256 + wid * 32 + r32;
#pragma unroll
        for (int d0 = 0; d0 < 4; ++d0) { const f32x4 g0 = *(const f32x4*)(qgain + d0 * 16 + hi * 8), g1 = *(const f32x4*)(qgain + d0 * 16 + hi * 8 + 4);
#pragma unroll
            for (int e = 0; e < 8; ++e) y[d0][e] *= rh * (e < 4 ? g0[e & 3] : g1[e & 3]); }
#pragma unroll
        for (int hf = 0; hf < 2; ++hf) {
            const int ir = hf ? (tq & 63) : (tq >> 6);
            const f32x4 c0 = *(const f32x4*)(rope + ir * 16 + 8 * hi), c1 = *(const f32x4*)(rope + ir * 16 + 8 * hi + 4);
            const f32x4 s0 = *(const f32x4*)(rope + 1024 + ir * 16 + 8 * hi), s1 = *(const f32x4*)(rope + 1024 + ir * 16 + 8 * hi + 4);
            u32x4 wa, wb; unsigned* pa = (unsigned*)&wa; unsigned* pb = (unsigned*)&wb; (void)pa; (void)pb;
            float oa[8], ob[8];
#pragma unroll
            for (int e = 0; e < 8; ++e) { const float c = (e < 4 ? c0[e & 3] : c1[e & 3]), sn = (e < 4 ? s0[e & 3] : s1[e & 3]); const float x1 = y[2 * hf][e], x2 = y[2 * hf + 1][e];
                oa[e] = x1 * c - x2 * sn; ob[e] = x2 * c + x1 * sn; }
            wa.x = cvt_pk_bf16(oa[0], oa[1]); wa.y = cvt_pk_bf16(oa[2], oa[3]); wa.z = cvt_pk_bf16(oa[4], oa[5]); wa.w = cvt_pk_bf16(oa[6], oa[7]);
            wb.x = cvt_pk_bf16(ob[0], ob[1]); wb.y = cvt_pk_bf16(ob[2], ob[3]); wb.z = cvt_pk_bf16(ob[4], ob[5]); wb.w = cvt_pk_bf16(ob[6], ob[7]);
            qf[2 * hf] = __builtin_bit_cast(bf16x8, wa); qf[2 * hf + 1] = __builtin_bit_cast(bf16x8, wb);
        }
    }
    *(LAS u32x4*)(lds + kdst) = krA; *(LAS u32x4*)(lds + vdst) = vrA; *(LAS u32x4*)(lds + 8192 + kdst) = krB;
    asm volatile("s_waitcnt vmcnt(0) lgkmcnt(0)\n\ts_barrier" ::: "memory");
    krA = *(const u32x4*)(ksrc + (size_t)2 * 64 * EVEN_IN); vrA = *(const u32x4*)(vsrc + (size_t)64 * EVEN_IN);
    const int koff = hi * 1024 + r32 * 16;
    const int voff = 16384 + ((lane >> 4) & 1) * 32 + (lane & 3) * 8 + (4 * hi + ((lane & 15) >> 2)) * 64;
    float mref, lsum = 0.f;
    f32x16 o0 = {}, o1 = {}, pA0 = {}, pA1 = {}, pB0, pB1;
    {
#pragma unroll
        for (int d0 = 0; d0 < 4; ++d0) {
            const bf16x8 k0 = *(const LAS bf16x8*)(lds + koff + d0 * 2048), k1 = *(const LAS bf16x8*)(lds + koff + d0 * 2048 + 512);
            pA0 = MFMA32(k0, qf[d0], pA0); pA1 = MFMA32(k1, qf[d0], pA1);
        }
        mref = rowmax32(pA0, pA1);
#pragma unroll
        for (int r = 0; r < 16; ++r) { pA0[r] -= mref; pA1[r] -= mref; }
    }
    f32x16 negm;
#pragma unroll
    for (int r = 0; r < 16; ++r) negm[r] = -mref;
    constexpr int NT = SEQ / 64;
    constexpr float THR = 8.0f;
    for (int t = 0; t < NT; t += 2) {
        ASTEP(t, pA0, pA1, pB0, pB1, krA, vrA, krB, vrB);
        ASTEP(t + 1, pB0, pB1, pA0, pA1, krB, vrB, krA, vrA);
    }
    lsum += __shfl_xor(lsum, 32);
    const float inv = 1.0f / lsum;
    bf16_t* op = P + qrow * EVEN_IN + 1792 + h * 64 + 4 * hi;
    u32x2 zq[8];
#pragma unroll
    for (int i = 0; i < 4; ++i) { zq[i] = *(const u32x2*)(op + 8 * i); zq[4 + i] = *(const u32x2*)(op + 32 + 8 * i); }
    if (!dry)
#pragma unroll
    for (int i = 0; i < 4; ++i) {
        { const u32x2 z = zq[i]; u32x2 w;
          w.x = cvt_pk_bf16(o0[4 * i] * inv * silu_f(bflo(z.x)), o0[4 * i + 1] * inv * silu_f(bfhi(z.x))); w.y = cvt_pk_bf16(o0[4 * i + 2] * inv * silu_f(bflo(z.y)), o0[4 * i + 3] * inv * silu_f(bfhi(z.y))); *(u32x2*)(op + 8 * i) = w; }
        { const u32x2 z = zq[4 + i]; u32x2 w;
          w.x = cvt_pk_bf16(o1[4 * i] * inv * silu_f(bflo(z.x)), o1[4 * i + 1] * inv * silu_f(bfhi(z.x))); w.y = cvt_pk_bf16(o1[4 * i + 2] * inv * silu_f(bflo(z.y)), o1[4 * i + 3] * inv * silu_f(bfhi(z.y))); *(u32x2*)(op + 32 + 8 * i) = w; }
    }
}

__device__ __forceinline__ void pool_loadU(u32x4 (&ur)[10], const bf16_t* P, int it, int tid) {
    const int t0 = (it & 63) * 64; const size_t rowbase = (size_t)(it >> 6) * SEQ;
#pragma unroll
    for (int i = 0; i < 10; ++i) {
        const int idx = tid + 512 * i, row = idx >> 6, ch = idx & 63, t = t0 - 8 + row;
        u32x4 v = {0u, 0u, 0u, 0u};
        if (t >= 0 && t < SEQ) v = *(const u32x4*)(P + (rowbase + t) * EVEN_IN + ch * 8);
        ur[i] = v;
    }
}
__device__ __forceinline__ void pool_run(LAS unsigned char* lds, bf16_t* P, const bf16_t* pwT, const float* pscale, int it0, int step, int tid, int lane, int wid, bool dry) {
    LAS unsigned char* U = lds; LAS unsigned char* DF = lds + 81920;
    u32x4 ur[10];
    if (it0 < 768) pool_loadU(ur, P, it0, tid);
    for (int it = it0; it < 768; it += step) {
    const int t0 = (it & 63) * 64; const size_t rowbase = (size_t)(it >> 6) * SEQ;
    u32x2 zz[8][2];
    { const int g = wid >> 1, th = wid & 1, fr = lane & 15, fq = lane >> 4;
#pragma unroll
      for (int db = 0; db < 8; ++db)
#pragma unroll
          for (int tb = 0; tb < 2; ++tb)
              zz[db][tb] = *(const u32x2*)(P + (rowbase + t0 + 32 * th + 16 * tb + fr) * EVEN_IN + 512 + g * 128 + 16 * db + 4 * fq); }
#pragma unroll
    for (int i = 0; i < 10; ++i) { const int idx = tid + 512 * i; *(LAS u32x4*)(U + (idx >> 6) * 1024 + (idx & 63) * 16) = ur[i]; }
    __syncthreads();
    if (it + step < 768) pool_loadU(ur, P, it + step, tid);
    bf16x8 af0[8];
    { const int g = wid >> 1, fr = lane & 15, fq = lane >> 4;
#pragma unroll
      for (int db = 0; db < 8; ++db) af0[db] = *(const bf16x8*)(pwT + ((size_t)(g * 128 + 16 * db + fr) * 128 + 8 * fq)); }
    {
        const int cp = tid & 255, half = tid >> 8, g = cp >> 6, w2 = 1 << g, tl0 = half * 32;
        const LAS unsigned* U32 = (const LAS unsigned*)U; LAS unsigned* D32 = (LAS unsigned*)DF;
        float sx = 0.f, sy = 0.f;
        for (int r = tl0 + 8 - w2; r < tl0 + 8 + w2; ++r) { const unsigned w = U32[r * 256 + cp]; sx += bflo(w); sy += bfhi(w); }
#pragma unroll 8
        for (int i = 0; i < 32; ++i) {
            const int tl = tl0 + i, t = t0 + tl;
            const int lo = (t - w2) < 0 ? 0 : (t - w2), hi2 = (t + w2) > SEQ ? SEQ : (t + w2);
            const float inv = 1.0f / (float)(hi2 - lo);
            const unsigned w = U32[(tl + 8) * 256 + cp];
            D32[tl * 260 + cp] = cvt_pk_bf16(sx * inv - bflo(w), sy * inv - bfhi(w));
            const unsigned wa = U32[(tl + 8 + w2) * 256 + cp], wb = U32[(tl + 8 - w2) * 256 + cp];
            sx += bflo(wa) - bflo(wb); sy += bfhi(wa) - bfhi(wb);
        }
    }
    __syncthreads();
    {
        const int g = wid >> 1, th = wid & 1, fr = lane & 15, fq = lane >> 4;
        f32x4 acc[8][2];
#pragma unroll
        for (int db = 0; db < 8; ++db) { acc[db][0] = (f32x4){0.f, 0.f, 0.f, 0.f}; acc[db][1] = (f32x4){0.f, 0.f, 0.f, 0.f}; }
#pragma unroll
        for (int ks = 0; ks < 4; ++ks) {
            const bf16x8 b0 = *(const LAS bf16x8*)(DF + (32 * th + fr) * 1040 + (g * 128 + 32 * ks + 8 * fq) * 2);
            const bf16x8 b1 = *(const LAS bf16x8*)(DF + (32 * th + 16 + fr) * 1040 + (g * 128 + 32 * ks + 8 * fq) * 2);
#pragma unroll
            for (int db = 0; db < 8; ++db) {
                const bf16x8 af = (ks == 0) ? af0[db] : *(const bf16x8*)(pwT + ((size_t)(g * 128 + 16 * db + fr) * 128 + 32 * ks + 8 * fq));
                acc[db][0] = MFMA16(af, b0, acc[db][0]); acc[db][1] = MFMA16(af, b1, acc[db][1]);
            }
        }
#pragma unroll
        for (int db = 0; db < 8; ++db) {
            const int col = g * 128 + 16 * db + 4 * fq;
            const f32x4 sc = *(const f32x4*)(pscale + col);
#pragma unroll
            for (int tb = 0; tb < 2; ++tb) {
                const int t = 32 * th + 16 * tb + fr;
                u32x2* pp = (u32x2*)(P + (rowbase + t0 + t) * EVEN_IN + 512 + col);
                const u32x2 z = zz[db][tb]; const f32x4 a = acc[db][tb] * sc; u32x2 w;
                w.x = cvt_pk_bf16(a[0] * silu_f(bflo(z.x)), a[1] * silu_f(bfhi(z.x))); w.y = cvt_pk_bf16(a[2] * silu_f(bflo(z.y)), a[3] * silu_f(bfhi(z.y))); if (!dry) *pp = w;
            }
        }
    }
    __syncthreads();
    }
}

__device__ __forceinline__ void sgu_item(LAS unsigned char* lds, bf16_t* P, const bf16_t* wsb, const float* bs, const float* sg, const float* ssv, int ch, int h, bool load_w, int tid, int lane, int wid, bool dry) {
    LAS unsigned char* GV = lds; LAS unsigned char* WT = lds + 36864; LAS unsigned char* GU = lds + 71680; LAS unsigned char* SZ = lds + 106496;
    const size_t row0 = (size_t)ch * 128;
#pragma unroll
    for (int i = 0; i < 4; ++i) {
        const int idx = tid + 512 * i, r = idx >> 4, c16 = idx & 15;
        const bf16_t* src = P + (row0 + r) * ODD_IN + h * 128 + c16 * 8;
        const u32x4 gu = *(const u32x4*)src, gv = *(const u32x4*)(src + 1024), sz = *(const u32x4*)(src + 2048);
        float part = ssv[(row0 + r) * 16 + c16];
        part += __shfl_xor(part, 1); part += __shfl_xor(part, 2); part += __shfl_xor(part, 4); part += __shfl_xor(part, 8);
        const float rv = __builtin_amdgcn_rsqf(part * (1.0f / 1024.0f) + EPS);
        const f32x4 g0 = *(const f32x4*)(sg + h * 128 + c16 * 8) * rv, g1 = *(const f32x4*)(sg + h * 128 + c16 * 8 + 4) * rv;
        u32x4 gn;
        gn.x = cvt_pk_bf16(bflo(gv.x) * g0[0], bfhi(gv.x) * g0[1]); gn.y = cvt_pk_bf16(bflo(gv.y) * g0[2], bfhi(gv.y) * g0[3]);
        gn.z = cvt_pk_bf16(bflo(gv.z) * g1[0], bfhi(gv.z) * g1[1]); gn.w = cvt_pk_bf16(bflo(gv.w) * g1[2], bfhi(gv.w) * g1[3]);
        *(LAS u32x4*)(GV + r * 288 + c16 * 16) = gn;
        *(LAS u32x4*)(GU + r * 272 + c16 * 16) = gu;
        *(LAS u32x4*)(SZ + r * 272 + c16 * 16) = sz;
        if (load_w) *(LAS u32x4*)(WT + r * 272 + c16 * 16) = *(const u32x4*)(wsb + ((size_t)(h * 128 + r) * 128 + c16 * 8));
    }
    __syncthreads();
    {
        const int fr = lane & 15, fq = lane >> 4;
        bf16x8 af[4];
#pragma unroll
        for (int ks = 0; ks < 4; ++ks) {
            const LAS unsigned char* ap = GV + (32 * ks + 8 * fq + (fr >> 2)) * 288 + (16 * wid + 4 * (fr & 3)) * 2;
            const s16x4 a0 = vtr(ap), a1 = vtr(ap + 4 * 288);
            af[ks] = (bf16x8){a0[0], a0[1], a0[2], a0[3], a1[0], a1[1], a1[2], a1[3]};
        }
        f32x4 acc[8];
#pragma unroll
        for (int pb = 0; pb < 8; ++pb) acc[pb] = (f32x4){0.f, 0.f, 0.f, 0.f};
#pragma unroll
        for (int ks = 0; ks < 4; ++ks)
#pragma unroll
            for (int pb = 0; pb < 8; ++pb) {
                const bf16x8 bfr = *(const LAS bf16x8*)(WT + (16 * pb + fr) * 272 + (32 * ks + 8 * fq) * 2);
                acc[pb] = MFMA16(af[ks], bfr, acc[pb]);
            }
#pragma unroll
        for (int pb = 0; pb < 8; ++pb) {
            const int p = 16 * pb + fr; const float bias = bs[h * 128 + p];
            LAS u32x2* gp = (LAS u32x2*)(GU + p * 272 + (16 * wid + 4 * fq) * 2);
            const u32x2 gu = *gp, sz = *(const LAS u32x2*)(SZ + p * 272 + (16 * wid + 4 * fq) * 2);
            u32x2 w;
            const f32x4 ug = gelu4((f32x4){bflo(gu.x), bfhi(gu.x), bflo(gu.y), bfhi(gu.y)});
            const f32x4 zs = silu4((f32x4){bflo(sz.x), bfhi(sz.x), bflo(sz.y), bfhi(sz.y)});
            w.x = cvt_pk_bf16(ug[0] * (acc[pb][0] + bias) * zs[0], ug[1] * (acc[pb][1] + bias) * zs[1]);
            w.y = cvt_pk_bf16(ug[2] * (acc[pb][2] + bias) * zs[2], ug[3] * (acc[pb][3] + bias) * zs[3]);
            *gp = w;
        }
    }
    __syncthreads();
#pragma unroll
    for (int i = 0; i < 4; ++i) {
        const int idx = tid + 512 * i, r = idx >> 4, c16 = idx & 15;
        if (!dry) *(u32x4*)(P + (row0 + r) * ODD_IN + h * 128 + c16 * 8) = *(const LAS u32x4*)(GU + r * 272 + c16 * 16);
    }
    __syncthreads();
}


__device__ __forceinline__ void sgu_load(u32x4 (&gu)[4], u32x4 (&gv)[4], u32x4 (&sz)[4], float (&part)[4], const bf16_t* P, const float* ssv, int ch, int h, int tid) {
    const size_t row0 = (size_t)ch * 128;
#pragma unroll
    for (int i = 0; i < 4; ++i) {
        const int idx = tid + 512 * i, r = idx >> 4, c16 = idx & 15;
        const bf16_t* src = P + (row0 + r) * ODD_IN + h * 128 + c16 * 8;
        gu[i] = *(const u32x4*)src; gv[i] = *(const u32x4*)(src + 1024); sz[i] = *(const u32x4*)(src + 2048);
        part[i] = ssv[(row0 + r) * 16 + c16];
    }
}
__device__ __forceinline__ void sgu_run(LAS unsigned char* lds, bf16_t* P, const bf16_t* wsb, const float* bs, const float* sg, const float* ssv, int ch0, int cstep, int h, int tid, int lane, int wid, bool dry) {
    LAS unsigned char* GV = lds; LAS unsigned char* WT = lds + 36864; LAS unsigned char* GU = lds + 71680; LAS unsigned char* SZ = lds + 106496;
    u32x4 gu[4], gv[4], sz[4]; float part[4];
    if (ch0 < 384) sgu_load(gu, gv, sz, part, P, ssv, ch0, h, tid);
    bool first = true;
    const f32x4 sg0 = *(const f32x4*)(sg + h * 128 + (tid & 15) * 8), sg1 = *(const f32x4*)(sg + h * 128 + (tid & 15) * 8 + 4);
    for (int ch = ch0; ch < 384; ch += cstep) {
        const size_t row0 = (size_t)ch * 128;
#pragma unroll
        for (int i = 0; i < 4; ++i) {
            const int idx = tid + 512 * i, r = idx >> 4, c16 = idx & 15;
            float pt = part[i];
            pt += __shfl_xor(pt, 1); pt += __shfl_xor(pt, 2); pt += __shfl_xor(pt, 4); pt += __shfl_xor(pt, 8);
            const float rv = __builtin_amdgcn_rsqf(pt * (1.0f / 1024.0f) + EPS);
            const f32x4 g0 = sg0 * rv, g1 = sg1 * rv;
            u32x4 gn;
            gn.x = cvt_pk_bf16(bflo(gv[i].x) * g0[0], bfhi(gv[i].x) * g0[1]); gn.y = cvt_pk_bf16(bflo(gv[i].y) * g0[2], bfhi(gv[i].y) * g0[3]);
            gn.z = cvt_pk_bf16(bflo(gv[i].z) * g1[0], bfhi(gv[i].z) * g1[1]); gn.w = cvt_pk_bf16(bflo(gv[i].w) * g1[2], bfhi(gv[i].w) * g1[3]);
            *(LAS u32x4*)(GV + r * 288 + c16 * 16) = gn;
            *(LAS u32x4*)(GU + r * 272 + c16 * 16) = gu[i];
            *(LAS u32x4*)(SZ + r * 272 + c16 * 16) = sz[i];
            if (first) *(LAS u32x4*)(WT + r * 272 + c16 * 16) = *(const u32x4*)(wsb + ((size_t)(h * 128 + r) * 128 + c16 * 8));
        }
        first = false;
        __syncthreads();
        if (ch + cstep < 384) sgu_load(gu, gv, sz, part, P, ssv, ch + cstep, h, tid);
        {
            const int fr = lane & 15, fq = lane >> 4;
            bf16x8 af[4];
#pragma unroll
            for (int ks = 0; ks < 4; ++ks) {
                const LAS unsigned char* ap = GV + (32 * ks + 8 * fq + (fr >> 2)) * 288 + (16 * wid + 4 * (fr & 3)) * 2;
                const s16x4 a0 = vtr(ap), a1 = vtr(ap + 4 * 288);
                af[ks] = (bf16x8){a0[0], a0[1], a0[2], a0[3], a1[0], a1[1], a1[2], a1[3]};
            }
            f32x4 acc[8];
#pragma unroll
            for (int pb = 0; pb < 8; ++pb) acc[pb] = (f32x4){0.f, 0.f, 0.f, 0.f};
#pragma unroll
            for (int ks = 0; ks < 4; ++ks)
#pragma unroll
                for (int pb = 0; pb < 8; ++pb) {
                    const bf16x8 bfr = *(const LAS bf16x8*)(WT + (16 * pb + fr) * 272 + (32 * ks + 8 * fq) * 2);
                    acc[pb] = MFMA16(af[ks], bfr, acc[pb]);
                }
#pragma unroll
            for (int pb = 0; pb < 8; ++pb) {
                const int p = 16 * pb + fr; const float bias = bs[h * 128 + p];
                LAS u32x2* gp = (LAS u32x2*)(GU + p * 272 + (16 * wid + 4 * fq) * 2);
                const u32x2 gu2 = *gp, sz2 = *(const LAS u32x2*)(SZ + p * 272 + (16 * wid + 4 * fq) * 2);
                u32x2 w;
                const f32x4 ug = gelu4((f32x4){bflo(gu2.x), bfhi(gu2.x), bflo(gu2.y), bfhi(gu2.y)});
                const f32x4 zs = silu4((f32x4){bflo(sz2.x), bfhi(sz2.x), bflo(sz2.y), bfhi(sz2.y)});
                w.x = cvt_pk_bf16(ug[0] * (acc[pb][0] + bias) * zs[0], ug[1] * (acc[pb][1] + bias) * zs[1]);
                w.y = cvt_pk_bf16(ug[2] * (acc[pb][2] + bias) * zs[2], ug[3] * (acc[pb][3] + bias) * zs[3]);
                *gp = w;
            }
        }
        __syncthreads();
#pragma unroll
        for (int i = 0; i < 4; ++i) {
            const int idx = tid + 512 * i, r = idx >> 4, c16 = idx & 15;
            if (!dry) *(u32x4*)(P + (row0 + r) * ODD_IN + h * 128 + c16 * 8) = *(const LAS u32x4*)(GU + r * 272 + c16 * 16);
        }
        __syncthreads();
    }
}

#define XB_TMO      128
#define XB_XCNT(j)  (256  + 64 * (j))
#define XB_XSUB(j)  (1280 + 64 * (j))
#define XB_XGEN(j)  (2304 + 64 * (j))
#define XB_TOP      3328
#define XB_TOPGEN   3392
#define XCD_BAR_WORDS 3456
#define XB_SPIN_CAP (1u << 18)

__device__ __forceinline__ unsigned xb_ld(unsigned* p)              { return __hip_atomic_load(p, __ATOMIC_RELAXED, __HIP_MEMORY_SCOPE_AGENT); }
__device__ __forceinline__ unsigned xb_add(unsigned* p, unsigned v) { return __hip_atomic_fetch_add(p, v, __ATOMIC_RELAXED, __HIP_MEMORY_SCOPE_AGENT); }
__device__ __forceinline__ unsigned xb_xcc_id() { return (unsigned)__builtin_amdgcn_s_getreg((3 << 11) | 20) & 0xFu; }
#define XB_SPIN(cond, bar) do { unsigned _sp = 0; while (cond) { __builtin_amdgcn_s_sleep(1); \
    if ((++_sp & 255u) == 0u) { if (xb_ld(&(bar)[XB_TMO])) break; if (_sp > XB_SPIN_CAP) { atomicAdd(&(bar)[XB_TMO], 1u); break; } } } } while (0)

struct XcdBarrier {
    unsigned* bar; unsigned x;
    volatile LAS unsigned* st;
};

__device__ __forceinline__ XcdBarrier xcd_barrier_post(unsigned* bar, volatile LAS unsigned* st) {
    XcdBarrier b; b.bar = bar; b.x = xb_xcc_id(); b.st = st;
    if (threadIdx.x == 0) st[2] = xb_add(&bar[XB_XCNT(b.x)], 1u) + 1u;
    return b;
}
__device__ __forceinline__ void xcd_barrier_complete(unsigned* bar, unsigned x, unsigned& nloc, unsigned& nx) {
    const unsigned G = gridDim.x * gridDim.y * gridDim.z;
    unsigned sum, cnt, mine, sp = 0u;
    for (;;) {
        sum = 0u; cnt = 0u; mine = 0u;
#pragma unroll
        for (unsigned j = 0; j < 16; ++j) { const unsigned c = xb_ld(&bar[XB_XCNT(j)]); sum += c; cnt += (c > 0u) ? 1u : 0u; mine = (j == x) ? c : mine; }
        if (sum == G) break;
        __builtin_amdgcn_s_sleep(1);
        if ((++sp & 255u) == 0u) { if (xb_ld(&bar[XB_TMO])) break; if (sp > XB_SPIN_CAP) { atomicAdd(&bar[XB_TMO], 1u); break; } }
    }
    nloc = mine > 0u ? mine : 1u; nx = cnt > 0u ? cnt : 1u;
}

__device__ __forceinline__ void xcd_barrier(const XcdBarrier& b) {
    asm volatile("s_waitcnt vmcnt(0)" ::: "memory");
    __syncthreads();
    if (threadIdx.x == 0) {
        unsigned* bar = b.bar;
        __builtin_amdgcn_s_waitcnt(0);
        unsigned nloc = b.st[0], nx = b.st[1];
        if (nloc == 0u) { xcd_barrier_complete(bar, b.x, nloc, nx); b.st[0] = nloc; b.st[1] = nx; }
        const unsigned old = xb_add(&bar[XB_XSUB(b.x)], 1u);
        const unsigned gen = old / nloc;
        if (old + 1u == (gen + 1u) * nloc) {
            __builtin_amdgcn_fence(__ATOMIC_RELEASE, "agent");
            asm volatile("s_waitcnt vmcnt(0)" ::: "memory");
            const unsigned og = xb_add(&bar[XB_TOP], 1u);
            const unsigned tg = og / nx;
            if (og + 1u == (tg + 1u) * nx) xb_add(&bar[XB_TOPGEN], 1u);
            else XB_SPIN(xb_ld(&bar[XB_TOPGEN]) == tg, bar);
            __builtin_amdgcn_fence(__ATOMIC_ACQUIRE, "agent");
            xb_add(&bar[XB_XGEN(b.x)], 1u);
            asm volatile("s_waitcnt vmcnt(0)" ::: "memory");
        } else {
            XB_SPIN(xb_ld(&bar[XB_XGEN(b.x)]) == gen, bar);
            __builtin_amdgcn_fence(__ATOMIC_ACQUIRE, "agent");
            asm volatile("s_waitcnt vmcnt(0)" ::: "memory");
        }
    }
    __syncthreads();
}

#ifdef DIAG
#define DG(k) (DIAG == (k))
#else
#define DG(k) true
#endif
__global__ void __launch_bounds__(512, 2) fwd_kernel(Args a) {
    extern __shared__ __attribute__((aligned(16))) unsigned char lds_raw[];
    LAS unsigned char* lds = (LAS unsigned char*)lds_raw;
    const int wid = __builtin_amdgcn_readfirstlane(threadIdx.x >> 6);
    const int G = gridDim.x, bx0 = blockIdx.x;
    int bx = bx0;
    unsigned char* ws = a.ws;
    bf16_t* P = (bf16_t*)(ws + WS_P); bf16_t* XB = (bf16_t*)(ws + WS_XB);
    float* SS = (float*)(ws + WS_SS); float* SSV = (float*)(ws + WS_SSV);
    const float* rope = (const float*)(ws + WS_ROPE);
    if (threadIdx.x < 4) ((LAS unsigned*)(lds + BARW_OFF))[threadIdx.x] = 0u;
    __syncthreads();
    XcdBarrier xbar = xcd_barrier_post((unsigned*)(ws + WS_BAR), (volatile LAS unsigned*)(lds + BARW_OFF));
    for (int ph = a.ph_lo; ph < a.ph_hi; ++ph) {
        if (ph > 0 && ((ph - 1) & 3) == 1 && (((ph - 1) >> 2) & 1)) continue;
#ifdef PROBE_KIND
        const int kind = (ph == 0) ? 0 : ((((ph - 1) & 3) == 2) ? ((((ph - 1) >> 2) & 1) ? 3 : 2) : 1);
        const int nrep = (kind == PROBE_KIND && a.ph_lo == 0) ? 2 : 1;
#else
        const int nrep = 1;
#endif
        for (int rep = 0; rep < nrep; ++rep) {
        const bool dry = (rep + 1 < nrep);
        if (rep) { __syncthreads(); cg::this_grid().sync(); }
        int tid = threadIdx.x; asm volatile("" : "+v"(tid));
        const int lane = tid & 63;
        if (ph == 0) {
            if (DG(0)) prologue(a, lds, tid, lane, wid);
            __syncthreads();
        } else {
            const int layer = (ph - 1) >> 2, sub4 = (ph - 1) & 3, j = layer >> 1; const bool even = (layer & 1) == 0;
            const int sub = (sub4 == 0) ? 0 : (sub4 == 1 ? 3 : sub4 - 1);
            if (sub == 3) {
                kprep_phase(P, a.in[7] + j * 64, rope, tid, bx, G);
            } else if (sub == 0) {
                if (even) {
                    pg8::Gemm g{XB, (const bf16_t*)(ws + WS_WINE) + (size_t)j * 2304 * 1024, MTOK, EVEN_IN, 1024, 1024, 0};
                    pg8::StaticOrder S; S.init(MTOK, EVEN_IN, G, bx);
                    pg8::EpiEvenIn E{P, SS, (LAS float*)(lds + RST_OFF)};
                    if (DG(1)) pg8::gemm_phase(lds, g, S, E, tid);
                } else {
                    pg8::Gemm g{XB, (const bf16_t*)(ws + WS_WINO) + (size_t)j * 3072 * 1024, MTOK, ODD_IN, 1024, 1024, 0};
                    pg8::StaticOrder S; S.init(MTOK, ODD_IN, G, bx);
                    pg8::EpiOddIn E{P, SS, SSV, (LAS float*)(lds + RST_OFF)};
                    if (DG(2)) pg8::gemm_phase(lds, g, S, E, tid);
                }
            } else if (sub == 1) {
                if (even) {
                    const int x = bx & 7, y = bx >> 3, gpx = G >> 3;
                    const bool xcdmap = (G % 8 == 0);
                    for (int i = 0;; ++i) {
                        const int v = xcdmap ? ((i * 8 + x) * gpx + y) : (i * G + bx);
                        if (v >= 1536) break;
                        const int grp = v >> 6, w = v & 63;
                        if (DG(3)) attn_unit(lds, P, a.in[6] + j * 64, rope, grp >> 1, (grp & 1) * 4 + (w >> 4), w & 15, lane, wid, dry);
                    }
                    const bf16_t* pwT = (const bf16_t*)(ws + WS_POOLW) + (size_t)j * 4 * 128 * 128;
                    if (DG(4)) pool_run(lds, P, pwT, a.in[5] + j * 512, bx, G, tid, lane, wid, dry);
                } else {
                    const bf16_t* wsb = (const bf16_t*)(ws + WS_WSB) + (size_t)j * 8 * 128 * 128;
                    int hprev = -1;
                    if (G % 8 == 0) {
                        const int h = bx & 7;
                        if (DG(5)) sgu_run(lds, P, wsb, a.in[13] + j * 1024, a.in[11] + j * 1024, SSV, bx >> 3, G >> 3, h, tid, lane, wid, dry);
                    } else {
                        for (int it = bx; it < 3072; it += G) { const int h = it & 7; if (DG(5)) sgu_item(lds, P, wsb, a.in[13] + j * 1024, a.in[11] + j * 1024, SSV, it >> 3, h, h != hprev, tid, lane, wid, dry); hprev = h; }
                    }
                }
            } else {
                if (even) {
                    pg8::Gemm g{P + 512, (const bf16_t*)(ws + WS_WOUTE) + (size_t)j * 1024 * 1024, MTOK, 1024, 1024, EVEN_IN, 1536};
                    pg8::StaticOrder S; S.init(MTOK, 1024, G, bx);
                    pg8::EpiOut E{a.out, layer == 0 ? a.in[0] : a.out, layer == 0 ? a.in[1] - (size_t)MPROMPT * DM : a.out, XB, SS, dry, layer == 3};
                    if (DG(6)) pg8::gemm_phase(lds, g, S, E, tid);
                } else {
                    pg8::Gemm g{P, (const bf16_t*)(ws + WS_WOUTO) + (size_t)j * 1024 * 1024, MTOK, 1024, 1024, ODD_IN, 0};
                    pg8::StaticOrder S; S.init(MTOK, 1024, G, bx);
                    pg8::EpiOut E{a.out, layer == 0 ? a.in[0] : a.out, layer == 0 ? a.in[1] - (size_t)MPROMPT * DM : a.out, XB, SS, dry, layer == 3};
                    if (DG(6)) pg8::gemm_phase(lds, g, S, E, tid);
                }
            }
        }
        }
        if (ph + 1 < a.ph_hi) { if (a.ph_hi > NPHASE) cg::this_grid().sync(); else xcd_barrier(xbar); }
        if (ph == a.ph_lo && ph + 1 < a.ph_hi) {
            volatile LAS unsigned* st = (volatile LAS unsigned*)(lds + BARW_OFF);
            if (threadIdx.x == 0) {
                unsigned* bar = (unsigned*)(ws + WS_BAR); bool ok = (G % 8 == 0) && (xbar.x < 8u);
                for (unsigned jx = 0; jx < 8; ++jx) ok = ok && (xb_ld(&bar[XB_XCNT(jx)]) == (unsigned)(G / 8));
                st[3] = ok ? 1u : 0u;
            }
            __syncthreads();
            if (st[3]) bx = __builtin_amdgcn_readfirstlane((int)xbar.x + 8 * (int)(st[2] - 1u));
        }
    }
}

extern "C" void kernel_launch(void* const* d_in, const int* in_sizes, int n_in, void* d_out, int out_size, void* d_ws, size_t ws_size, hipStream_t stream) {
    static int grid = 0;
    if (grid == 0) {
        if (n_in != 15 || out_size != MTOK * DM || ws_size < WS_END) { fprintf(stderr, "kernel_launch: unexpected shapes (n_in %d out %d ws %zu need %zu)\n", n_in, out_size, ws_size, (size_t)WS_END); grid = -1; return; }
        int dev = 0, cus = 0, per_cu = 0;
        (void)hipGetDevice(&dev);
        (void)hipDeviceGetAttribute(&cus, hipDeviceAttributeMultiprocessorCount, dev);
        if (hipFuncSetAttribute((const void*)fwd_kernel, hipFuncAttributeMaxDynamicSharedMemorySize, LDS_BYTES) != hipSuccess) { fprintf(stderr, "kernel_launch: hipFuncSetAttribute failed\n"); grid = -1; return; }
        if (hipOccupancyMaxActiveBlocksPerMultiprocessor(&per_cu, (const void*)fwd_kernel, 512, LDS_BYTES) != hipSuccess || per_cu < 1) { fprintf(stderr, "kernel_launch: occupancy query gave %d\n", per_cu); per_cu = 1; }
        (void)hipGetLastError();
        grid = cus * per_cu;
        if (grid <= 0) grid = 256;
    }
    if (grid < 0) return;
    (void)hipMemsetAsync((char*)d_ws + WS_BAR, 0, 16384, stream);
    Args a{};
    for (int i = 0; i < 15; ++i) a.in[i] = (const float*)d_in[i];
    a.out = (float*)d_out; a.ws = (unsigned char*)d_ws;
#if N_LAUNCH_MODE == 1
    a.ph_lo = 0; a.ph_hi = NPHASE;
    void* args[] = {&a};
    hipError_t e = hipLaunchCooperativeKernel((const void*)fwd_kernel, dim3(grid), dim3(512), args, LDS_BYTES, stream);
    if (e != hipSuccess) fprintf(stderr, "cooperative launch failed: %s (grid %d)\n", hipGetErrorString(e), grid);
#else
    for (int ph = 0; ph < NPHASE; ++ph) {
        a.ph_lo = ph; a.ph_hi = ph + 1;
        hipLaunchKernelGGL(fwd_kernel, dim3(grid), dim3(512), LDS_BYTES, stream, a);
    }
#endif
}
```

```cpp
#include <hip/hip_runtime.h>
#include <hip/hip_cooperative_groups.h>
#include <cstdio>
#include <cstdint>
namespace cg = cooperative_groups;

#define LAS __attribute__((address_space(3)))
typedef unsigned short bf16_t;
typedef short bf16x8 __attribute__((ext_vector_type(8)));
typedef short s16x4 __attribute__((ext_vector_type(4)));
typedef float f32x2 __attribute__((ext_vector_type(2)));
typedef float f32x4 __attribute__((ext_vector_type(4)));
typedef float f32x16 __attribute__((ext_vector_type(16)));
typedef unsigned u32x2 __attribute__((ext_vector_type(2)));
typedef unsigned u32x4 __attribute__((ext_vector_type(4)));

#ifndef N_LAUNCH_MODE
#define N_LAUNCH_MODE 1
#endif

constexpr int DM = 1024, SEQ = 4096, NSEQ = 12, MTOK = NSEQ * SEQ, MPROMPT = 8 * SEQ;
constexpr int EVEN_IN = 2304, ODD_IN = 3072;
constexpr float EPS = 1e-6f;
constexpr float C2 = 0.125f * 1.4426950408889634f;
constexpr int NPHASE = 17;

constexpr size_t WS_WINE = 0;
constexpr size_t WS_WOUTE = WS_WINE + 2ull * 2304 * 1024 * 2;
constexpr size_t WS_WINO = WS_WOUTE + 2ull * 1024 * 1024 * 2;
constexpr size_t WS_WOUTO = WS_WINO + 2ull * 3072 * 1024 * 2;
constexpr size_t WS_POOLW = WS_WOUTO + 2ull * 1024 * 1024 * 2;
constexpr size_t WS_WSB = WS_POOLW + 2ull * 4 * 128 * 128 * 2;
constexpr size_t WS_ROPE = WS_WSB + 2ull * 8 * 128 * 128 * 2;
constexpr size_t WS_BAR = WS_ROPE + 8192;
constexpr size_t WS_SS = 32ull << 20;
constexpr size_t WS_SSV = WS_SS + (size_t)MTOK * 16 * 4;
constexpr size_t WS_XB = 40ull << 20;
constexpr size_t WS_P = WS_XB + (size_t)MTOK * 1024 * 2;
constexpr size_t WS_END = WS_P + (size_t)MTOK * 3072 * 2;
static_assert(WS_BAR + 16384 <= WS_SS && WS_SSV + (size_t)MTOK * 64 <= WS_XB, "ws map");

constexpr int LDS_BYTES = 159760;
constexpr int BARW_OFF = 159744;
constexpr int XL_OFF = 131072;
constexpr int ROPE_OFF = 139264;
constexpr int RST_OFF = 147456;

__device__ __forceinline__ unsigned cvt_pk_bf16(float lo, float hi) { unsigned r; asm volatile("v_cvt_pk_bf16_f32 %0, %1, %2" : "=v"(r) : "v"(lo), "v"(hi)); return r; }
__device__ __forceinline__ float bflo(unsigned w) { return __uint_as_float(w << 16); }
__device__ __forceinline__ float bfhi(unsigned w) { return __uint_as_float(w & 0xffff0000u); }
__device__ __forceinline__ float silu_f(float v) { return v * __builtin_amdgcn_rcpf(1.f + __builtin_amdgcn_exp2f(-1.4426950408889634f * v)); }
__device__ __forceinline__ float wave_sum(float v) {
#pragma unroll
    for (int o = 1; o < 64; o <<= 1) v += __shfl_xor(v, o);
    return v;
}
#define LDS_WAIT() asm volatile("s_waitcnt lgkmcnt(0)" ::: "memory")
__device__ __forceinline__ f32x2 gelu_pk(f32x2 v) {
    const f32x2 av = __builtin_elementwise_abs(v), d = av * 0.2316418882f + 1.0f;
    f32x2 t; t.x = __builtin_amdgcn_rcpf(d.x); t.y = __builtin_amdgcn_rcpf(d.y);
    f32x2 q = t * 0.5307027145f + (-0.7265760135f); q = q * t + 0.7107068705f; q = q * t + (-0.142248368f); q = q * t + 0.127414796f; q = q * t;
    const f32x2 s = (v * v) * (-0.72134752044f);
    f32x2 e; e.x = __builtin_amdgcn_exp2f(s.x); e.y = __builtin_amdgcn_exp2f(s.y);
    const f32x2 m = v * (q * e), r = v - m;
    f32x2 o; o.x = v.x < 0.f ? m.x : r.x; o.y = v.y < 0.f ? m.y : r.y; return o;
}
__device__ __forceinline__ f32x4 gelu4(f32x4 v) { f32x2 a = gelu_pk((f32x2){v[0], v[1]}), b = gelu_pk((f32x2){v[2], v[3]}); return (f32x4){a.x, a.y, b.x, b.y}; }
__device__ __forceinline__ f32x4 silu4(f32x4 v) { return (f32x4){silu_f(v[0]), silu_f(v[1]), silu_f(v[2]), silu_f(v[3])}; }

__device__ __forceinline__ u32x4 pack8(f32x4 a, f32x4 b) { u32x4 w; w.x = cvt_pk_bf16(a[0], a[1]); w.y = cvt_pk_bf16(a[2], a[3]); w.z = cvt_pk_bf16(b[0], b[1]); w.w = cvt_pk_bf16(b[2], b[3]); return w; }
__device__ __forceinline__ float sq4(f32x4 a) { return (a[0] * a[0] + a[1] * a[1]) + (a[2] * a[2] + a[3] * a[3]); }
__device__ __forceinline__ float fq_sum(float s) {
    const auto a = __builtin_amdgcn_permlane16_swap(__float_as_uint(s), __float_as_uint(s), false, false);
    const float t = __uint_as_float(a[0]) + __uint_as_float(a[1]);
    const auto b = __builtin_amdgcn_permlane32_swap(__float_as_uint(t), __float_as_uint(t), false, false);
    return __uint_as_float(b[0]) + __uint_as_float(b[1]);
}
__device__ __forceinline__ float xor32(float v, bool lo) {
    const auto a = __builtin_amdgcn_permlane32_swap(__float_as_uint(v), __float_as_uint(v), false, false);
    return __uint_as_float(lo ? a[1] : a[0]);
}
__device__ __forceinline__ float row_rstd(const float* ss, int row, int fq) {
    const f32x4 p = *(const f32x4*)(ss + (size_t)row * 16 + 4 * fq);
    const float s = fq_sum((p[0] + p[1]) + (p[2] + p[3]));
    return __builtin_amdgcn_rsqf(s * (1.0f / 1024.0f) + EPS);
}

__device__ __forceinline__ void store_rows64(LAS unsigned char* st, bf16_t* base, size_t pitch, u32x4 val, int fr, int fq, int lane) {
    *(LAS u32x4*)(st + fr * 80 + fq * 16) = val;
    const u32x4 t = *(const LAS u32x4*)(st + (lane >> 2) * 80 + (lane & 3) * 16);
    *(u32x4*)(base + (size_t)(lane >> 2) * pitch + (lane & 3) * 8) = t;
}
namespace pg8 {
constexpr int BM = 256, BK = 64, HALF = 128, HTB = HALF * BK * 2, STAGE_BYTES = 8 * HTB, NXCD = 8, WGM = 8;
__host__ __device__ __forceinline__ int lds_byte(int r, int c) { const int st = (r >> 4) * 2 + (c >> 5), rr = r & 15, cc = c & 31, ob = rr * 64 + cc * 2; return st * 1024 + (ob ^ (((ob >> 9) & 1) << 5)); }
__host__ __device__ __forceinline__ void stage_rc(int b, int& R, int& C) { const int st = b / 1024, sb = b % 1024, swz = sb ^ (((sb >> 9) & 1) << 5); R = (st >> 1) * 16 + swz / 64; C = (st & 1) * 32 + (swz % 64) / 2; }
__host__ __device__ __forceinline__ int perm32(int rho) { const int n = rho >> 4, i = rho & 15; return 8 * (i >> 2) + 4 * n + (i & 3); }

struct Unit { int pm, pn; };
struct Gemm { const bf16_t* A; const bf16_t* Bt; int M, N, K, lda, xtra; };

struct StaticOrder {
    int nM, nN, nwg, G, c;
    __host__ __device__ void init(int M, int N, int G_, int c_) { nM = M / BM; nN = N / BM; nwg = nM * nN; G = G_; c = c_; }
    __host__ __device__ bool next(int i, Unit& u) const {
        const long L = (long)i * G + c; if (L >= nwg) return false;
        int wgid = (int)L; { const int q = nwg / NXCD, r = nwg % NXCD, xcd = wgid % NXCD, off = wgid / NXCD; wgid = (xcd < r ? xcd * (q + 1) : r * (q + 1) + (xcd - r) * q) + off; }
        const int nig = WGM * nN, gid = wgid / nig, fm = gid * WGM, gsz = (nM - fm) < WGM ? (nM - fm) : WGM;
        u.pm = fm + ((wgid % nig) % gsz); u.pn = (wgid % nig) / gsz; return true;
    }
};

template <class Epi>
__device__ __forceinline__ void gemm_phase(LAS unsigned char* lds, const Gemm g, const StaticOrder& S, const Epi& E, const int tid) {
    const int wid = __builtin_amdgcn_readfirstlane(tid >> 6), lane = tid & 63, wr = wid >> 2, wc = wid & 3, fr = lane & 15, fq = lane >> 4;
    const int K = g.K, nt = K / BK, lda = g.lda;
    unsigned voffA[2], voffB[2];
#pragma unroll
    for (int i = 0; i < 2; ++i) { int R, C; stage_rc(tid * 16 + i * 8192, R, C); const int Rb = (R & ~31) + perm32(R & 31);
        voffA[i] = (unsigned)(R * lda + C) * 2u; voffB[i] = (unsigned)(Rb * K + C) * 2u; }
    const size_t kstep = (size_t)(BK * 2);
    const size_t hstepA = (size_t)HALF * lda * 2, tstepA = 2 * hstepA;
    const size_t hstepB = (size_t)HALF * K * 2, tstepB = 2 * hstepB;
    const size_t xtra = (size_t)g.xtra;
    const unsigned ldsw = (unsigned)wid * 1024u;
    const int aoff = lds_byte(wr * 64 + fr, fq * 8), boff = lds_byte(wc * 32 + fr, fq * 8);
#define PG8_SA(b, h) (((b) * 2 + (h)) * HTB)
#define PG8_SB(b, h) ((4 + (b) * 2 + (h)) * HTB)
#define PG8_STAGE(bufoff, gbase, voff) do { _Pragma("unroll") for (int _i = 0; _i < 2; ++_i) \
        __builtin_amdgcn_global_load_lds((const unsigned*)((const char*)(gbase) + (voff)[_i]), (LAS unsigned*)(lds + (bufoff) + ldsw + _i * 8192), 16, 0, 0); } while (0)
#define PG8_LDA(dst, b, h) do { _Pragma("unroll") for (int m = 0; m < 4; ++m) _Pragma("unroll") for (int k = 0; k < 2; ++k) dst[m][k] = *(const LAS bf16x8*)(lds + PG8_SA(b, h) + aoff + m * 2048 + k * 1024); } while (0)
#define PG8_LDB(dst, b, h) do { _Pragma("unroll") for (int n = 0; n < 2; ++n) _Pragma("unroll") for (int k = 0; k < 2; ++k) dst[n][k] = *(const LAS bf16x8*)(lds + PG8_SB(b, h) + boff + n * 2048 + k * 1024); } while (0)
#define PG8_MMA(ai, bj, At, Bt) do { __builtin_amdgcn_s_setprio(1); _Pragma("unroll") for (int m = 0; m < 4; ++m) _Pragma("unroll") for (int n = 0; n < 2; ++n) _Pragma("unroll") for (int k = 0; k < 2; ++k) \
        acc[ai][bj][m][n] = __builtin_amdgcn_mfma_f32_16x16x32_bf16(Bt[n][k], At[m][k], acc[ai][bj][m][n], 0, 0, 0); __builtin_amdgcn_s_setprio(0); } while (0)
#define PG8_WAIT_V(n) asm volatile("s_waitcnt vmcnt(" #n ")" ::: "memory")
#define PG8_WAIT_L(n) asm volatile("s_waitcnt lgkmcnt(" #n ")" ::: "memory")
#define PG8_BAR __builtin_amdgcn_s_barrier()
#define PG8_SCHED __builtin_amdgcn_sched_barrier(0)
    Unit cur, nxt; int ui = 0;
    if (!S.next(0, cur)) return;
    f32x4 acc[2][2][4][2];
#pragma unroll
    for (int a = 0; a < 2; ++a)
#pragma unroll
        for (int b = 0; b < 2; ++b)
#pragma unroll
            for (int m = 0; m < 4; ++m)
#pragma unroll
                for (int n = 0; n < 2; ++n) acc[a][b][m][n] = (f32x4){0.f, 0.f, 0.f, 0.f};
    bf16x8 At[4][2], B0[2][2], B1[2][2];
    const char* cA = (const char*)g.A + (size_t)cur.pm * tstepA; const char* cB = (const char*)g.Bt + (size_t)cur.pn * tstepB;
    f32x4 pf[2];
    E.pre(cur.pm, tid, pf); E.post(0, tid, pf);
    PG8_STAGE(PG8_SB(0, 0), cB, voffB); PG8_STAGE(PG8_SB(0, 1), cB + hstepB, voffB); PG8_STAGE(PG8_SA(0, 0), cA, voffA); PG8_STAGE(PG8_SA(0, 1), cA + hstepA, voffA);
    if (wr == 1) PG8_BAR;
    PG8_WAIT_V(2); PG8_BAR;
    PG8_STAGE(PG8_SB(1, 0), cB + kstep, voffB); PG8_STAGE(PG8_SA(1, 0), cA + kstep, voffA); PG8_STAGE(PG8_SB(1, 1), cB + hstepB + kstep, voffB);
    PG8_WAIT_V(6); PG8_BAR;
    for (;;) {
        const bool has_next = S.next(ui + 1, nxt);
        const char* nA = has_next ? (const char*)g.A + (size_t)nxt.pm * tstepA : cA; const char* nB = has_next ? (const char*)g.Bt + (size_t)nxt.pn * tstepB : cB;
        for (int t = 0; t < nt; t += 2) {
            const bool last = (t == nt - 2);
            const char* a1 = cA + (size_t)(t + 1) * kstep + ((t + 1) >= 8 ? xtra : 0);
            const char* a2 = last ? nA : cA + (size_t)(t + 2) * kstep + ((t + 2) >= 8 ? xtra : 0); const char* b2 = last ? nB : cB + (size_t)(t + 2) * kstep;
            const char* a3 = a2 + kstep; const char* b3 = b2 + kstep;
            PG8_LDB(B0, 0, 0); PG8_LDB(B1, 0, 1); PG8_SCHED; PG8_LDA(At, 0, 0); PG8_STAGE(PG8_SA(1, 1), a1 + hstepA, voffA);
            PG8_WAIT_V(8); PG8_WAIT_L(0); PG8_BAR; PG8_MMA(0, 0, At, B0); PG8_MMA(0, 1, At, B1); PG8_BAR; PG8_SCHED;
            PG8_LDA(At, 0, 1); PG8_STAGE(PG8_SB(0, 0), b2, voffB); PG8_STAGE(PG8_SB(0, 1), b2 + hstepB, voffB); PG8_STAGE(PG8_SA(0, 0), a2, voffA);
            PG8_WAIT_V(8); PG8_WAIT_L(0); PG8_BAR; PG8_MMA(1, 0, At, B0); PG8_MMA(1, 1, At, B1); PG8_BAR; PG8_SCHED;
            PG8_LDB(B0, 1, 0); PG8_LDB(B1, 1, 1); PG8_SCHED; PG8_LDA(At, 1, 0); PG8_STAGE(PG8_SA(0, 1), a2 + hstepA, voffA);
            PG8_WAIT_V(8); PG8_WAIT_L(0); PG8_BAR; PG8_MMA(0, 0, At, B0); PG8_MMA(0, 1, At, B1); PG8_BAR; PG8_SCHED;
            PG8_LDA(At, 1, 1); PG8_STAGE(PG8_SB(1, 0), b3, voffB); PG8_STAGE(PG8_SB(1, 1), b3 + hstepB, voffB); PG8_STAGE(PG8_SA(1, 0), a3, voffA);
            PG8_WAIT_V(8); PG8_WAIT_L(0); PG8_BAR; PG8_MMA(1, 0, At, B0); PG8_MMA(1, 1, At, B1); PG8_BAR; PG8_SCHED;
        }
        if (wr == 0) PG8_BAR;
        if (has_next) E.pre(nxt.pm, tid, pf);
        E(acc, cur, wr, wc, fr, fq, ui & 1);
        if (has_next) E.post((ui + 1) & 1, tid, pf);
        if (!has_next) break;
#pragma unroll
        for (int a = 0; a < 2; ++a)
#pragma unroll
            for (int b = 0; b < 2; ++b)
#pragma unroll
                for (int m = 0; m < 4; ++m)
#pragma unroll
                    for (int n = 0; n < 2; ++n) acc[a][b][m][n] = (f32x4){0.f, 0.f, 0.f, 0.f};
        cur = nxt; cA = nA; cB = nB; ++ui;
        if (wr == 1) PG8_BAR;
    }
    PG8_WAIT_V(0);
    PG8_BAR;
#undef PG8_SA
#undef PG8_SB
#undef PG8_STAGE
#undef PG8_LDA
#undef PG8_LDB
#undef PG8_MMA
#undef PG8_WAIT_V
#undef PG8_WAIT_L
#undef PG8_BAR
#undef PG8_SCHED
}

struct EpiEvenIn {
    bf16_t* P; const float* ss; LAS float* rst;
    __device__ __forceinline__ void pre(int pm, int tid, f32x4 (&r)[2]) const {
        const float* p = ss + ((size_t)pm * BM + (tid >> 1)) * 16 + 8 * (tid & 1);
        r[0] = *(const f32x4*)p; r[1] = *(const f32x4*)(p + 4);
    }
    __device__ __forceinline__ void post(int slot, int tid, const f32x4 (&r)[2]) const {
        const f32x4 t = r[0] + r[1]; float s = (t[0] + t[1]) + (t[2] + t[3]);
        s += __shfl_xor(s, 1);
        if ((tid & 1) == 0) rst[slot * 256 + (tid >> 1)] = __builtin_amdgcn_rsqf(s * (1.0f / 1024.0f) + EPS);
    }
    __device__ __forceinline__ void operator()(const f32x4 (&acc)[2][2][4][2], const Unit& u, int wr, int wc, int fr_, int fq_, int slot) const {
        int fr = fr_, fq = fq_; asm volatile("" : "+v"(fr), "+v"(fq));
        const int pn = u.pn;
        const int col0 = pn * BM + wc * 32 + 8 * fq;
        float rs[2][4];
#pragma unroll
        for (int ai = 0; ai < 2; ++ai)
#pragma unroll
            for (int m = 0; m < 4; ++m) rs[ai][m] = rst[slot * 256 + ai * HALF + wr * 64 + m * 16 + fr];
#pragma unroll
        for (int ai = 0; ai < 2; ++ai)
#pragma unroll
            for (int m = 0; m < 4; ++m) {
                bf16_t* rowp = P + (size_t)(u.pm * BM + ai * HALF + wr * 64 + m * 16 + fr) * EVEN_IN + col0;
#pragma unroll
                for (int bj = 0; bj < 2; ++bj) {
                    f32x4 v0 = acc[ai][bj][m][0] * rs[ai][m], v1 = acc[ai][bj][m][1] * rs[ai][m];
                    *(u32x4*)(rowp + bj * HALF) = pack8(v0, v1);
                }
                asm volatile("" ::: "memory");
            }
    }
};

struct EpiOddIn {
    bf16_t* P; const float* ss; float* ssv; LAS float* rst;
    __device__ __forceinline__ void pre(int pm, int tid, f32x4 (&r)[2]) const {
        const float* p = ss + ((size_t)pm * BM + (tid >> 1)) * 16 + 8 * (tid & 1);
        r[0] = *(const f32x4*)p; r[1] = *(const f32x4*)(p + 4);
    }
    __device__ __forceinline__ void post(int slot, int tid, const f32x4 (&r)[2]) const {
        const f32x4 t = r[0] + r[1]; float s = (t[0] + t[1]) + (t[2] + t[3]);
        s += __shfl_xor(s, 1);
        if ((tid & 1) == 0) rst[slot * 256 + (tid >> 1)] = __builtin_amdgcn_rsqf(s * (1.0f / 1024.0f) + EPS);
    }
    __device__ __forceinline__ void operator()(const f32x4 (&acc)[2][2][4][2], const Unit& u, int wr, int wc, int fr_, int fq_, int slot) const {
        int fr = fr_, fq = fq_; asm volatile("" : "+v"(fr), "+v"(fq));
        const int pn = u.pn, col0 = pn * BM + wc * 32 + 8 * fq;
        float rs[2][4];
#pragma unroll
        for (int ai = 0; ai < 2; ++ai)
#pragma unroll
            for (int m = 0; m < 4; ++m) rs[ai][m] = rst[slot * 256 + ai * HALF + wr * 64 + m * 16 + fr];
#pragma unroll
        for (int ai = 0; ai < 2; ++ai)
#pragma unroll
            for (int m = 0; m < 4; ++m) {
                const int row = u.pm * BM + ai * HALF + wr * 64 + m * 16 + fr;
                const float r = rs[ai][m];
                bf16_t* rowp = P + (size_t)row * ODD_IN + col0;
                float sq = 0.f;
#pragma unroll
                for (int bj = 0; bj < 2; ++bj) {
                    f32x4 v0 = acc[ai][bj][m][0] * r, v1 = acc[ai][bj][m][1] * r;
                    if (pn >= 4 && pn < 8) { v0 = gelu4(v0); v1 = gelu4(v1); sq += sq4(v0) + sq4(v1); }
                    *(u32x4*)(rowp + bj * HALF) = pack8(v0, v1);
                }
                if (pn >= 4 && pn < 8) { sq = fq_sum(sq); if (fq == 0) ssv[(size_t)row * 16 + (pn - 4) * 4 + wc] = sq; }
                asm volatile("" ::: "memory");
            }
    }
};

struct EpiOut {
    float* X; const float* R0; const float* R1; bf16_t* XB; float* ss; bool dry; bool lastl;
    __device__ __forceinline__ void pre(int, int, f32x4 (&)[2]) const {}
    __device__ __forceinline__ void post(int, int, const f32x4 (&)[2]) const {}
    __device__ __forceinline__ void load2(f32x4 (&xv)[2][2][2], const float* rb, int b) const {
#pragma unroll
        for (int mm = 0; mm < 2; ++mm) {
            const float* xp = rb + (size_t)((b >> 1) * HALF + (2 * (b & 1) + mm) * 16) * DM;
#pragma unroll
            for (int bj = 0; bj < 2; ++bj) { xv[mm][bj][0] = *(const f32x4*)(xp + bj * HALF); xv[mm][bj][1] = *(const f32x4*)(xp + bj * HALF + 4); }
        }
    }
    __device__ __forceinline__ void operator()(const f32x4 (&acc)[2][2][4][2], const Unit& u, int wr, int wc, int fr_, int fq_, int slot) const {
        int fr = fr_, fq = fq_; asm volatile("" : "+v"(fr), "+v"(fq));
        const int pn = u.pn, col0 = pn * BM + wc * 32 + 8 * fq;
        const float* rb = ((u.pm * BM < MPROMPT) ? R0 : R1) + (size_t)(u.pm * BM + wr * 64 + fr) * DM + col0;
        f32x4 xa[2][2][2], xb2[2][2][2];
        load2(xa, rb, 0);
#pragma unroll
        for (int b = 0; b < 4; ++b) {
            if (b + 1 < 4) { if (b & 1) load2(xa, rb, b + 1); else load2(xb2, rb, b + 1); }
            const int ai = b >> 1;
#pragma unroll
            for (int mm = 0; mm < 2; ++mm) {
                const int m = 2 * (b & 1) + mm;
                const int row = u.pm * BM + ai * HALF + wr * 64 + m * 16 + fr;
                float* xp = X + (size_t)row * DM + col0; bf16_t* bp = XB + (size_t)row * DM + col0;
                float sq = 0.f;
#pragma unroll
                for (int bj = 0; bj < 2; ++bj) {
                    const f32x4 x0 = ((b & 1) ? xb2[mm][bj][0] : xa[mm][bj][0]) + acc[ai][bj][m][0], x1 = ((b & 1) ? xb2[mm][bj][1] : xa[mm][bj][1]) + acc[ai][bj][m][1];
                    if (!dry) { *(f32x4*)(xp + bj * HALF) = x0; *(f32x4*)(xp + bj * HALF + 4) = x1;
                    if (!lastl) *(u32x4*)(bp + bj * HALF) = pack8(x0, x1); }
                    sq += sq4(x0) + sq4(x1);
                }
                if (!lastl) { sq = fq_sum(sq); if (fq == 0 && !dry) ss[(size_t)row * 16 + pn * 4 + wc] = sq; }
            }
        }
    }
};
}

__device__ __forceinline__ void p0_transpose_item(const float* W, int K, int N, bf16_t* WT, const float* gk, LAS float* scr, int item, int lane) {
    const int nblk = N / 32, kb = item / nblk, nb = item % nblk, k0 = 64 * kb, n0 = 32 * nb;
#pragma unroll
    for (int i = 0; i < 8; ++i) {
        const int kk = 8 * i + (lane >> 3); f32x4 v = *(const f32x4*)(W + (size_t)(k0 + kk) * N + n0 + 4 * (lane & 7));
        if (gk) v = v * gk[k0 + kk];
        LAS float* d = scr + kk * 33 + 4 * (lane & 7); d[0] = v[0]; d[1] = v[1]; d[2] = v[2]; d[3] = v[3];
    }
    LDS_WAIT(); asm volatile("" ::: "memory");
    const int c = lane & 7;
#pragma unroll
    for (int j = 0; j < 4; ++j) { const int n = (lane >> 3) + 8 * j; const LAS float* s = scr + (8 * c) * 33 + n;
        u32x4 o; o.x = cvt_pk_bf16(s[0 * 33], s[1 * 33]); o.y = cvt_pk_bf16(s[2 * 33], s[3 * 33]); o.z = cvt_pk_bf16(s[4 * 33], s[5 * 33]); o.w = cvt_pk_bf16(s[6 * 33], s[7 * 33]);
        *(u32x4*)(WT + (size_t)(n0 + n) * K + k0 + 8 * c) = o; }
    LDS_WAIT(); asm volatile("" ::: "memory");
}

struct Args { const float* in[15]; float* out; unsigned char* ws; int ph_lo, ph_hi; };

__device__ __forceinline__ void prologue(const Args& a, LAS unsigned char* lds, int tid, int lane, int wid) {
    unsigned char* ws = a.ws;
    const int G = gridDim.x, gw = blockIdx.x * 8 + wid, NGW = G * 8;
    LAS float* scr = (LAS float*)(lds + wid * 16384);
    constexpr int I_INE = 16 * 72, I_OUT = 16 * 32, I_INO = 16 * 96, I_POOL = 2 * 4;
    constexpr int NITEMS = 2 * (I_INE + I_OUT + I_INO + I_OUT) + 8 * I_POOL;
    for (int it = gw; it < NITEMS; it += NGW) {
        int r = it;
        if (r < 2 * I_INE) { const int j = r / I_INE; p0_transpose_item(a.in[3] + (size_t)j * 1024 * 2304, 1024, 2304, (bf16_t*)(ws + WS_WINE) + (size_t)j * 2304 * 1024, a.in[2] + j * 1024, scr, r % I_INE, lane); continue; } r -= 2 * I_INE;
        if (r < 2 * I_OUT) { const int j = r / I_OUT; p0_transpose_item(a.in[8] + (size_t)j * 1024 * 1024, 1024, 1024, (bf16_t*)(ws + WS_WOUTE) + (size_t)j * 1024 * 1024, nullptr, scr, r % I_OUT, lane); continue; } r -= 2 * I_OUT;
        if (r < 2 * I_INO) { const int j = r / I_INO; p0_transpose_item(a.in[10] + (size_t)j * 1024 * 3072, 1024, 3072, (bf16_t*)(ws + WS_WINO) + (size_t)j * 3072 * 1024, a.in[9] + j * 1024, scr, r % I_INO, lane); continue; } r -= 2 * I_INO;
        if (r < 2 * I_OUT) { const int j = r / I_OUT; p0_transpose_item(a.in[14] + (size_t)j * 1024 * 1024, 1024, 1024, (bf16_t*)(ws + WS_WOUTO) + (size_t)j * 1024 * 1024, nullptr, scr, r % I_OUT, lane); continue; } r -= 2 * I_OUT;
        { const int mt = r / I_POOL; p0_transpose_item(a.in[4] + (size_t)mt * 128 * 128, 128, 128, (bf16_t*)(ws + WS_POOLW) + (size_t)mt * 128 * 128, nullptr, scr, r % I_POOL, lane); }
    }
    { const float* wsf = a.in[12]; bf16_t* dst = (bf16_t*)(ws + WS_WSB);
      for (int i = (blockIdx.x * 512 + tid) * 4; i < 2 * 8 * 128 * 128; i += G * 512 * 4) { const f32x4 v = *(const f32x4*)(wsf + i); u32x2 o; o.x = cvt_pk_bf16(v[0], v[1]); o.y = cvt_pk_bf16(v[2], v[3]); *(u32x2*)(dst + i) = o; } }
    { float* rope = (float*)(ws + WS_ROPE);
      for (int i = blockIdx.x * 512 + tid; i < 1024; i += G * 512) { const int idx = i >> 4, f = i & 15; const float inv = 1.0f / powf(10000.0f, (float)f / 16.0f); const float ang = (float)idx * inv; rope[i] = cosf(ang); rope[1024 + i] = sinf(ang); } }
    { const float* xp = a.in[0]; const float* xs = a.in[1]; float* ss = (float*)(ws + WS_SS); bf16_t* xb = (bf16_t*)(ws + WS_XB);
      for (int m = gw; m < MTOK; m += NGW) {
          const float* src = (m < MPROMPT) ? xp + (size_t)m * DM : xs + (size_t)(m - MPROMPT) * DM;
          f32x4 v[4]; float s = 0.f;
#pragma unroll
          for (int j = 0; j < 4; ++j) { v[j] = *(const f32x4*)(src + (lane + 64 * j) * 4); s += sq4(v[j]); }
          s = wave_sum(s);
#pragma unroll
          for (int j = 0; j < 4; ++j) { u32x2 o; o.x = cvt_pk_bf16(v[j][0], v[j][1]); o.y = cvt_pk_bf16(v[j][2], v[j][3]); *(u32x2*)(xb + (size_t)m * DM + (lane + 64 * j) * 4) = o; }
          if (lane < 16) ss[(size_t)m * 16 + lane] = (lane == 0) ? s : 0.f;
      } }
}

__device__ __forceinline__ void kprep_item(bf16_t* P, const f32x4 g0, const f32x4 g1, const float* rope, int idx, const u32x4 w) {
    const int e8 = idx & 7, hk = (idx >> 3) & 1, row = idx >> 4;
    float x[8] = {bflo(w.x), bfhi(w.x), bflo(w.y), bfhi(w.y), bflo(w.z), bfhi(w.z), bflo(w.w), bfhi(w.w)};
    float ssq = 0.f;
#pragma unroll
    for (int e = 0; e < 8; ++e) ssq += x[e] * x[e];
    ssq += __shfl_xor(ssq, 1); ssq += __shfl_xor(ssq, 2); ssq += __shfl_xor(ssq, 4);
    const float rh = __builtin_amdgcn_rsqf(ssq * (1.0f / 64.0f) + EPS);
    const int t = row & (SEQ - 1), ir = (e8 < 4) ? (t >> 6) : (t & 63), f0 = 8 * (e8 & 1);
    const f32x4 c0 = *(const f32x4*)(rope + ir * 16 + f0), c1 = *(const f32x4*)(rope + ir * 16 + f0 + 4);
    const f32x4 s0 = *(const f32x4*)(rope + 1024 + ir * 16 + f0), s1 = *(const f32x4*)(rope + 1024 + ir * 16 + f0 + 4);
    const float sgn = (e8 & 2) ? 1.0f : -1.0f;
    float o[8];
#pragma unroll
    for (int e = 0; e < 8; ++e) {
        const float y = x[e] * rh * (e < 4 ? g0[e & 3] : g1[e & 3]);
        const float other = __shfl_xor(y, 2);
        o[e] = y * (e < 4 ? c0[e & 3] : c1[e & 3]) + sgn * other * (e < 4 ? s0[e & 3] : s1[e & 3]);
    }
    u32x4 r; r.x = cvt_pk_bf16(o[0], o[1]); r.y = cvt_pk_bf16(o[2], o[3]); r.z = cvt_pk_bf16(o[4], o[5]); r.w = cvt_pk_bf16(o[6], o[7]);
    *(u32x4*)(P + (size_t)row * EVEN_IN + 1536 + hk * 64 + e8 * 8) = r;
}
__device__ __forceinline__ void kprep_phase(bf16_t* P, const float* kg, const float* rope, int tid, int bx, int G) {
    const f32x4 kg0 = *(const f32x4*)(kg + (tid & 7) * 8), kg1 = *(const f32x4*)(kg + (tid & 7) * 8 + 4);
    const int stride = G * 512;
    for (int base = bx * 512 + tid; base < MTOK * 16; base += 3 * stride) {
        u32x4 w[3];
#pragma unroll
        for (int q = 0; q < 3; ++q) { const int idx = base + q * stride; if (idx < MTOK * 16) w[q] = *(const u32x4*)(P + (size_t)(idx >> 4) * EVEN_IN + 1536 + ((idx >> 3) & 1) * 64 + (idx & 7) * 8); }
#pragma unroll
        for (int q = 0; q < 3; ++q) { const int idx = base + q * stride; if (idx < MTOK * 16) kprep_item(P, kg0, kg1, rope, idx, w[q]); }
    }
}

#define MFMA32(a, b, c) __builtin_amdgcn_mfma_f32_32x32x16_bf16(a, b, c, 0, 0, 0)
#define MFMA16(a, b, c) __builtin_amdgcn_mfma_f32_16x16x32_bf16(a, b, c, 0, 0, 0)
__device__ __forceinline__ s16x4 vtr(const LAS unsigned char* p) { return __builtin_bit_cast(s16x4, __builtin_amdgcn_ds_read_tr16_b64_v4i16((LAS s16x4*)p)); }
__device__ __forceinline__ float max3f(float a, float b, float c) { return __builtin_fmaxf(__builtin_fmaxf(a, b), c); }

#define ABAR() asm volatile("s_waitcnt lgkmcnt(0)\n\ts_barrier" ::: "memory")
#define SGB(mask, n) __builtin_amdgcn_sched_group_barrier(mask, n, 0)
typedef __bf16 bf16v2 __attribute__((ext_vector_type(2)));
__device__ __forceinline__ unsigned cvtpk(float a, float b) { const bf16v2 r = __builtin_convertvector((f32x2){a, b}, bf16v2); return __builtin_bit_cast(unsigned, r); }
__device__ __forceinline__ float pairmax(float m) { auto rr = __builtin_amdgcn_permlane32_swap(__float_as_uint(m), __float_as_uint(m), false, false); return __builtin_fmaxf(__uint_as_float(rr[0]), __uint_as_float(rr[1])); }
__device__ __forceinline__ float rowmax32(const f32x16& p0, const f32x16& p1) {
    float a = max3f(p0[0], p0[1], p1[0]), b = max3f(p0[2], p0[3], p1[1]); a = max3f(a, p1[2], p1[3]);
#pragma unroll
    for (int r = 4; r < 16; r += 4) { a = max3f(a, p0[r], p0[r + 1]); b = max3f(b, p0[r + 2], p0[r + 3]); a = max3f(a, p1[r], p1[r + 1]); b = max3f(b, p1[r + 2], p1[r + 3]); }
    return pairmax(__builtin_fmaxf(a, b));
}
#define SBAR() __builtin_amdgcn_sched_barrier(0)
#define PIN(x) asm volatile("" : "+v"(x))
#define VCHUNK(PC, KB, R) do { \
        float e0_ = __builtin_amdgcn_exp2f(PC[(R)]), e1_ = __builtin_amdgcn_exp2f(PC[(R) + 1]), e2_ = __builtin_amdgcn_exp2f(PC[(R) + 2]), e3_ = __builtin_amdgcn_exp2f(PC[(R) + 3]); \
        s0 += e0_; s1 += e1_; s2 += e2_; s3 += e3_; pw[KB][(R) / 2] = cvtpk(e0_, e1_); pw[KB][(R) / 2 + 1] = cvtpk(e2_, e3_); \
        PIN(pw[KB][(R) / 2]); PIN(pw[KB][(R) / 2 + 1]); PIN(s0); PIN(s1); PIN(s2); PIN(s3); } while (0)
#define VTR4(J) do { const LAS unsigned char* vb_ = vc + (J) * 1024; va0 = vtr(vb_); va1 = vtr(vb_ + 512); vb0 = vtr(vb_ + 4096); vb1 = vtr(vb_ + 4096 + 512); } while (0)
#define PVJ(J) do { const u32x4 pbw_ = {pw[(J) >> 1][4 * ((J) & 1)], pw[(J) >> 1][4 * ((J) & 1) + 1], pw[(J) >> 1][4 * ((J) & 1) + 2], pw[(J) >> 1][4 * ((J) & 1) + 3]}; \
        const bf16x8 pb_ = __builtin_bit_cast(bf16x8, pbw_); \
        const bf16x8 fa_ = {va0[0], va0[1], va0[2], va0[3], va1[0], va1[1], va1[2], va1[3]}; const bf16x8 fb_ = {vb0[0], vb0[1], vb0[2], vb0[3], vb1[0], vb1[1], vb1[2], vb1[3]}; \
        o0 = MFMA32(fa_, pb_, o0); o1 = MFMA32(fb_, pb_, o1); } while (0)
#define ASTEP(T, PC0, PC1, PN0, PN1, KRO, VRO, KRN, VRN) do { \
        const int t_ = (T); \
        if (t_ + 3 < NT) KRN = *(const u32x4*)(ksrc + (size_t)(t_ + 3) * 64 * EVEN_IN); \
        if (t_ + 2 < NT) VRN = *(const u32x4*)(vsrc + (size_t)(t_ + 2) * 64 * EVEN_IN); \
        const LAS unsigned char* kn = lds + ((t_ + 1) & 1) * 8192 + koff; \
        const LAS unsigned char* vc = lds + (t_ & 1) * 8192 + voff; \
        bf16x8 kf[8]; \
        _Pragma("unroll") for (int d0 = 0; d0 < 4; ++d0) { kf[2 * d0] = *(const LAS bf16x8*)(kn + d0 * 2048); kf[2 * d0 + 1] = *(const LAS bf16x8*)(kn + d0 * 2048 + 512); } \
        unsigned pw[2][8]; float s0 = 0.f, s1 = 0.f, s2 = 0.f, s3 = 0.f; s16x4 va0, va1, vb0, vb1; \
        SBAR(); \
        VCHUNK(PC0, 0, 0); VCHUNK(PC1, 1, 0); SBAR(); \
        PN0 = MFMA32(kf[0], qf[0], negm); VCHUNK(PC0, 0, 4); SBAR(); \
        PN1 = MFMA32(kf[1], qf[0], negm); VCHUNK(PC1, 1, 4); SBAR(); \
        PN0 = MFMA32(kf[2], qf[1], PN0); VCHUNK(PC0, 0, 8); SBAR(); \
        PN1 = MFMA32(kf[3], qf[1], PN1); VCHUNK(PC1, 1, 8); SBAR(); \
        PN0 = MFMA32(kf[4], qf[2], PN0); VCHUNK(PC0, 0, 12); SBAR(); \
        PN1 = MFMA32(kf[5], qf[2], PN1); VCHUNK(PC1, 1, 12); SBAR(); \
        PN0 = MFMA32(kf[6], qf[3], PN0); VTR4(0); lsum += (s0 + s1) + (s2 + s3); SBAR(); \
        PN1 = MFMA32(kf[7], qf[3], PN1); SBAR(); \
        PVJ(0); VTR4(1); \
        float ma_ = max3f(PN0[0], PN0[1], PN0[2]); ma_ = max3f(ma_, PN0[3], PN0[4]); ma_ = max3f(ma_, PN0[5], PN0[6]); ma_ = max3f(ma_, PN0[7], PN0[8]); PIN(ma_); SBAR(); \
        PVJ(1); VTR4(2); \
        ma_ = max3f(ma_, PN0[9], PN0[10]); ma_ = max3f(ma_, PN0[11], PN0[12]); ma_ = max3f(ma_, PN0[13], PN0[14]); ma_ = max3f(ma_, PN0[15], PN1[0]); PIN(ma_); SBAR(); \
        PVJ(2); VTR4(3); \
        float mb_ = max3f(PN1[1], PN1[2], PN1[3]); mb_ = max3f(mb_, PN1[4], PN1[5]); mb_ = max3f(mb_, PN1[6], PN1[7]); mb_ = max3f(mb_, PN1[8], PN1[9]); PIN(mb_); SBAR(); \
        PVJ(3); \
        mb_ = max3f(mb_, PN1[10], PN1[11]); mb_ = max3f(mb_, PN1[12], PN1[13]); mb_ = max3f(mb_, PN1[14], PN1[15]); \
        const float mt_ = pairmax(__builtin_fmaxf(ma_, mb_)); \
        SBAR(); \
        if (t_ + 2 < NT) *(LAS u32x4*)(lds + (t_ & 1) * 8192 + kdst) = KRO; \
        if (t_ + 1 < NT) *(LAS u32x4*)(lds + ((t_ + 1) & 1) * 8192 + vdst) = VRO; \
        if (__builtin_amdgcn_ballot_w64(mt_ > THR) != 0ull) { \
            const float d_ = __builtin_fmaxf(mt_, 0.f), alpha_ = __builtin_amdgcn_exp2f(-d_); \
            mref += d_; lsum *= alpha_; \
            _Pragma("unroll") for (int r = 0; r < 16; ++r) { o0[r] *= alpha_; o1[r] *= alpha_; PN0[r] -= d_; PN1[r] -= d_; negm[r] = -mref; } \
        } \
        ABAR(); } while (0)
__device__ __forceinline__ void attn_unit(LAS unsigned char* lds, bf16_t* P, const float* qgain, const float* rope, int s, int h, int qb, int lane, int wid, bool dry) {
    const int r32 = lane & 31, hi = lane >> 5, kvh = h >> 2;
    const size_t rowbase = (size_t)s * SEQ;
    const bf16_t* ksrc = P + (rowbase + lane) * EVEN_IN + 1536 + kvh * 64 + wid * 8;
    const bf16_t* vsrc = P + (rowbase + 16 * (wid & 3) + (lane >> 2)) * EVEN_IN + 1664 + kvh * 64 + (wid >> 2) * 32 + (lane & 3) * 8;
    const int kdst = wid * 1024 + lane * 16;
    const int vdst = 16384 + (wid >> 2) * 4096 + (16 * (wid & 3) + (lane >> 2)) * 64 + (lane & 3) * 16;
    const size_t qrow = rowbase + (size_t)qb * 256 + wid * 32 + r32;
    const bf16_t* qg = P + qrow * EVEN_IN + 1024 + h * 64 + hi * 8;
    u32x4 krA = *(const u32x4*)ksrc, vrA = *(const u32x4*)vsrc;
    u32x4 krB = *(const u32x4*)(ksrc + (size_t)64 * EVEN_IN), vrB;
    bf16x8 qf[4];
    {
        float y[4][8]; float ssq = 0.f;
#pragma unroll
        for (int d0 = 0; d0 < 4; ++d0) { const u32x4 w = *(const u32x4*)(qg + d0 * 16);
            y[d0][0] = bflo(w.x); y[d0][1] = bfhi(w.x); y[d0][2] = bflo(w.y); y[d0][3] = bfhi(w.y); y[d0][4] = bflo(w.z); y[d0][5] = bfhi(w.z); y[d0][6] = bflo(w.w); y[d0][7] = bfhi(w.w);
#pragma unroll
            for (int e = 0; e < 8; ++e) ssq += y[d0][e] * y[d0][e]; }
        { const auto rr = __builtin_amdgcn_permlane32_swap(__float_as_uint(ssq), __float_as_uint(ssq), false, false); ssq = __uint_as_float(rr[0]) + __uint_as_float(rr[1]); }
        const float rh = __builtin_amdgcn_rsqf(ssq * (1.0f / 64.0f) + EPS) * C2;
        const int tq = qb * 256 + wid * 32 + r32;
#pragma unroll
        for (int d0 = 0; d0 < 4; ++d0) { const f32x4 g0 = *(const f32x4*)(qgain + d0 * 16 + hi * 8), g1 = *(const f32x4*)(qgain + d0 * 16 + hi * 8 + 4);
#pragma unroll
            for (int e = 0; e < 8; ++e) y[d0][e] *= rh * (e < 4 ? g0[e & 3] : g1[e & 3]); }
#pragma unroll
        for (int hf = 0; hf < 2; ++hf) {
            const int ir = hf ? (tq & 63) : (tq >> 6);
            const f32x4 c0 = *(const f32x4*)(rope + ir * 16 + 8 * hi), c1 = *(const f32x4*)(rope + ir * 16 + 8 * hi + 4);
            const f32x4 s0 = *(const f32x4*)(rope + 1024 + ir * 16 + 8 * hi), s1 = *(const f32x4*)(rope + 1024 + ir * 16 + 8 * hi + 4);
            u32x4 wa, wb; unsigned* pa = (unsigned*)&wa; unsigned* pb = (unsigned*)&wb; (void)pa; (void)pb;
            float oa[8], ob[8];
#pragma unroll
            for (int e = 0; e < 8; ++e) { const float c = (e < 4 ? c0[e & 3] : c1[e & 3]), sn = (e < 4 ? s0[e & 3] : s1[e & 3]); const float x1 = y[2 * hf][e], x2 = y[2 * hf + 1][e];
                oa[e] = x1 * c - x2 * sn; ob[e] = x2 * c + x1 * sn; }
            wa.x = cvt_pk_bf16(oa[0], oa[1]); wa.y = cvt_pk_bf16(oa[2], oa[3]); wa.z = cvt_pk_bf16(oa[4], oa[5]); wa.w = cvt_pk_bf16(oa[6], oa[7]);
            wb.x = cvt_pk_bf16(ob[0], ob[1]); wb.y = cvt_pk_bf16(ob[2], ob[3]); wb.z = cvt_pk_bf16(ob[4], ob[5]); wb.w = cvt_pk_bf16(ob[6], ob[7]);
            qf[2 * hf] = __builtin_bit_cast(bf16x8, wa); qf[2 * hf + 1] = __builtin_bit_cast(bf16x8, wb);
        }
    }
    *(LAS u32x4*)(lds + kdst) = krA; *(LAS u32x4*)(lds + vdst) = vrA; *(LAS u32x4*)(lds + 8192 + kdst) = krB;
    asm volatile("s_waitcnt vmcnt(0) lgkmcnt(0)\n\ts_barrier" ::: "memory");
    krA = *(const u32x4*)(ksrc + (size_t)2 * 64 * EVEN_IN); vrA = *(const u32x4*)(vsrc + (size_t)64 * EVEN_IN);
    const int koff = hi * 1024 + r32 * 16;
    const int voff = 16384 + ((lane >> 4) & 1) * 32 + (lane & 3) * 8 + (4 * hi + ((lane & 15) >> 2)) * 64;
    float mref, lsum = 0.f;
    f32x16 o0 = {}, o1 = {}, pA0 = {}, pA1 = {}, pB0, pB1;
    {
#pragma unroll
        for (int d0 = 0; d0 < 4; ++d0) {
            const bf16x8 k0 = *(const LAS bf16x8*)(lds + koff + d0 * 2048), k1 = *(const LAS bf16x8*)(lds + koff + d0 * 2048 + 512);
            pA0 = MFMA32(k0, qf[d0], pA0); pA1 = MFMA32(k1, qf[d0], pA1);
        }
        mref = rowmax32(pA0, pA1);
#pragma unroll
        for (int r = 0; r < 16; ++r) { pA0[r] -= mref; pA1[r] -= mref; }
    }
    f32x16 negm;
#pragma unroll
    for (int r = 0; r < 16; ++r) negm[r] = -mref;
    constexpr int NT = SEQ / 64;
    constexpr float THR = 8.0f;
    for (int t = 0; t < NT; t += 2) {
        ASTEP(t, pA0, pA1, pB0, pB1, krA, vrA, krB, vrB);
        ASTEP(t + 1, pB0, pB1, pA0, pA1, krB, vrB, krA, vrA);
    }
    lsum += __shfl_xor(lsum, 32);
    const float inv = 1.0f / lsum;
    bf16_t* op = P + qrow * EVEN_IN + 1792 + h * 64 + 4 * hi;
    u32x2 zq[8];
#pragma unroll
    for (int i = 0; i < 4; ++i) { zq[i] = *(const u32x2*)(op + 8 * i); zq[4 + i] = *(const u32x2*)(op + 32 + 8 * i); }
    if (!dry)
#pragma unroll
    for (int i = 0; i < 4; ++i) {
        { const u32x2 z = zq[i]; u32x2 w;
          w.x = cvt_pk_bf16(o0[4 * i] * inv * silu_f(bflo(z.x)), o0[4 * i + 1] * inv * silu_f(bfhi(z.x))); w.y = cvt_pk_bf16(o0[4 * i + 2] * inv * silu_f(bflo(z.y)), o0[4 * i + 3] * inv * silu_f(bfhi(z.y))); *(u32x2*)(op + 8 * i) = w; }
        { const u32x2 z = zq[4 + i]; u32x2 w;
          w.x = cvt_pk_bf16(o1[4 * i] * inv * silu_f(bflo(z.x)), o1[4 * i + 1] * inv * silu_f(bfhi(z.x))); w.y = cvt_pk_bf16(o1[4 * i + 2] * inv * silu_f(bflo(z.y)), o1[4 * i + 3] * inv * silu_f(bfhi(z.y))); *(u32x2*)(op + 32 + 8 * i) = w; }
    }
}

__device__ __forceinline__ void pool_loadU(u32x4 (&ur)[10], const bf16_t* P, int it, int tid) {
    const int t0 = (it & 63) * 64; const size_t rowbase = (size_t)(it >> 6) * SEQ;
#pragma unroll
    for (int i = 0; i < 10; ++i) {
        const int idx = tid + 512 * i, row = idx >> 6, ch = idx & 63, t = t0 - 8 + row;
        u32x4 v = {0u, 0u, 0u, 0u};
        if (t >= 0 && t < SEQ) v = *(const u32x4*)(P + (rowbase + t) * EVEN_IN + ch * 8);
        ur[i] = v;
    }
}
__device__ __forceinline__ void pool_run(LAS unsigned char* lds, bf16_t* P, const bf16_t* pwT, const float* pscale, int it0, int step, int tid, int lane, int wid, bool dry) {
    LAS unsigned char* U = lds; LAS unsigned char* DF = lds + 81920;
    u32x4 ur[10];
    if (it0 < 768) pool_loadU(ur, P, it0, tid);
    for (int it = it0; it < 768; it += step) {
    const int t0 = (it & 63) * 64; const size_t rowbase = (size_t)(it >> 6) * SEQ;
    u32x2 zz[8][2];
    { const int g = wid >> 1, th = wid & 1, fr = lane & 15, fq = lane >> 4;
#pragma unroll
      for (int db = 0; db < 8; ++db)
#pragma unroll
          for (int tb = 0; tb < 2; ++tb)
              zz[db][tb] = *(const u32x2*)(P + (rowbase + t0 + 32 * th + 16 * tb + fr) * EVEN_IN + 512 + g * 128 + 16 * db + 4 * fq); }
#pragma unroll
    for (int i = 0; i < 10; ++i) { const int idx = tid + 512 * i; *(LAS u32x4*)(U + (idx >> 6) * 1024 + (idx & 63) * 16) = ur[i]; }
    __syncthreads();
    if (it + step < 768) pool_loadU(ur, P, it + step, tid);
    bf16x8 af0[8];
    { const int g = wid >> 1, fr = lane & 15, fq = lane >> 4;
#pragma unroll
      for (int db = 0; db < 8; ++db) af0[db] = *(const bf16x8*)(pwT + ((size_t)(g * 128 + 16 * db + fr) * 128 + 8 * fq)); }
    {
        const int cp = tid & 255, half = tid >> 8, g = cp >> 6, w2 = 1 << g, tl0 = half * 32;
        const LAS unsigned* U32 = (const LAS unsigned*)U; LAS unsigned* D32 = (LAS unsigned*)DF;
        float sx = 0.f, sy = 0.f;
        for (int r = tl0 + 8 - w2; r < tl0 + 8 + w2; ++r) { const unsigned w = U32[r * 256 + cp]; sx += bflo(w); sy += bfhi(w); }
#pragma unroll 8
        for (int i = 0; i < 32; ++i) {
            const int tl = tl0 + i, t = t0 + tl;
            const int lo = (t - w2) < 0 ? 0 : (t - w2), hi2 = (t + w2) > SEQ ? SEQ : (t + w2);
            const float inv = 1.0f / (float)(hi2 - lo);
            const unsigned w = U32[(tl + 8) * 256 + cp];
            D32[tl * 260 + cp] = cvt_pk_bf16(sx * inv - bflo(w), sy * inv - bfhi(w));
            const unsigned wa = U32[(tl + 8 + w2) * 256 + cp], wb = U32[(tl + 8 - w2) * 256 + cp];
            sx += bflo(wa) - bflo(wb); sy += bfhi(wa) - bfhi(wb);
        }
    }
    __syncthreads();
    {
        const int g = wid >> 1, th = wid & 1, fr = lane & 15, fq = lane >> 4;
        f32x4 acc[8][2];
#pragma unroll
        for (int db = 0; db < 8; ++db) { acc[db][0] = (f32x4){0.f, 0.f, 0.f, 0.f}; acc[db][1] = (f32x4){0.f, 0.f, 0.f, 0.f}; }
#pragma unroll
        for (int ks = 0; ks < 4; ++ks) {
            const bf16x8 b0 = *(const LAS bf16x8*)(DF + (32 * th + fr) * 1040 + (g * 128 + 32 * ks + 8 * fq) * 2);
            const bf16x8 b1 = *(const LAS bf16x8*)(DF + (32 * th + 16 + fr) * 1040 + (g * 128 + 32 * ks + 8 * fq) * 2);
#pragma unroll
            for (int db = 0; db < 8; ++db) {
                const bf16x8 af = (ks == 0) ? af0[db] : *(const bf16x8*)(pwT + ((size_t)(g * 128 + 16 * db + fr) * 128 + 32 * ks + 8 * fq));
                acc[db][0] = MFMA16(af, b0, acc[db][0]); acc[db][1] = MFMA16(af, b1, acc[db][1]);
            }
        }
#pragma unroll
        for (int db = 0; db < 8; ++db) {
            const int col = g * 128 + 16 * db + 4 * fq;
            const f32x4 sc = *(const f32x4*)(pscale + col);
#pragma unroll
            for (int tb = 0; tb < 2; ++tb) {
                const int t = 32 * th + 16 * tb + fr;
                u32x2* pp = (u32x2*)(P + (rowbase + t0 + t) * EVEN_IN + 512 + col);
                const u32x2 z = zz[db][tb]; const f32x4 a = acc[db][tb] * sc; u32x2 w;
                w.x = cvt_pk_bf16(a[0] * silu_f(bflo(z.x)), a[1] * silu_f(bfhi(z.x))); w.y = cvt_pk_bf16(a[2] * silu_f(bflo(z.y)), a[3] * silu_f(bfhi(z.y))); if (!dry) *pp = w;
            }
        }
    }
    __syncthreads();
    }
}

__device__ __forceinline__ void sgu_item(LAS unsigned char* lds, bf16_t* P, const bf16_t* wsb, const float* bs, const float* sg, const float* ssv, int ch, int h, bool load_w, int tid, int lane, int wid, bool dry) {
    LAS unsigned char* GV = lds; LAS unsigned char* WT = lds + 36864; LAS unsigned char* GU = lds + 71680; LAS unsigned char* SZ = lds + 106496;
    const size_t row0 = (size_t)ch * 128;
#pragma unroll
    for (int i = 0; i < 4; ++i) {
        const int idx = tid + 512 * i, r = idx >> 4, c16 = idx & 15;
        const bf16_t* src = P + (row0 + r) * ODD_IN + h * 128 + c16 * 8;
        const u32x4 gu = *(const u32x4*)src, gv = *(const u32x4*)(src + 1024), sz = *(const u32x4*)(src + 2048);
        float part = ssv[(row0 + r) * 16 + c16];
        part += __shfl_xor(part, 1); part += __shfl_xor(part, 2); part += __shfl_xor(part, 4); part += __shfl_xor(part, 8);
        const float rv = __builtin_amdgcn_rsqf(part * (1.0f / 1024.0f) + EPS);
        const f32x4 g0 = *(const f32x4*)(sg + h * 128 + c16 * 8) * rv, g1 = *(const f32x4*)(sg + h * 128 + c16 * 8 + 4) * rv;
        u32x4 gn;
        gn.x = cvt_pk_bf16(bflo(gv.x) * g0[0], bfhi(gv.x) * g0[1]); gn.y = cvt_pk_bf16(bflo(gv.y) * g0[2], bfhi(gv.y) * g0[3]);
        gn.z = cvt_pk_bf16(bflo(gv.z) * g1[0], bfhi(gv.z) * g1[1]); gn.w = cvt_pk_bf16(bflo(gv.w) * g1[2], bfhi(gv.w) * g1[3]);
        *(LAS u32x4*)(GV + r * 288 + c16 * 16) = gn;
        *(LAS u32x4*)(GU + r * 272 + c16 * 16) = gu;
        *(LAS u32x4*)(SZ + r * 272 + c16 * 16) = sz;
        if (load_w) *(LAS u32x4*)(WT + r * 272 + c16 * 16) = *(const u32x4*)(wsb + ((size_t)(h * 128 + r) * 128 + c16 * 8));
    }
    __syncthreads();
    {
        const int fr = lane & 15, fq = lane >> 4;
        bf16x8 af[4];
#pragma unroll
        for (int ks = 0; ks < 4; ++ks) {
            const LAS unsigned char* ap = GV + (32 * ks + 8 * fq + (fr >> 2)) * 288 + (16 * wid + 4 * (fr & 3)) * 2;
            const s16x4 a0 = vtr(ap), a1 = vtr(ap + 4 * 288);
            af[ks] = (bf16x8){a0[0], a0[1], a0[2], a0[3], a1[0], a1[1], a1[2], a1[3]};
        }
        f32x4 acc[8];
#pragma unroll
        for (int pb = 0; pb < 8; ++pb) acc[pb] = (f32x4){0.f, 0.f, 0.f, 0.f};
#pragma unroll
        for (int ks = 0; ks < 4; ++ks)
#pragma unroll
            for (int pb = 0; pb < 8; ++pb) {
                const bf16x8 bfr = *(const LAS bf16x8*)(WT + (16 * pb + fr) * 272 + (32 * ks + 8 * fq) * 2);
                acc[pb] = MFMA16(af[ks], bfr, acc[pb]);
            }
#pragma unroll
        for (int pb = 0; pb < 8; ++pb) {
            const int p = 16 * pb + fr; const float bias = bs[h * 128 + p];
            LAS u32x2* gp = (LAS u32x2*)(GU + p * 272 + (16 * wid + 4 * fq) * 2);
            const u32x2 gu = *gp, sz = *(const LAS u32x2*)(SZ + p * 272 + (16 * wid + 4 * fq) * 2);
            u32x2 w;
            const f32x4 ug = gelu4((f32x4){bflo(gu.x), bfhi(gu.x), bflo(gu.y), bfhi(gu.y)});
            const f32x4 zs = silu4((f32x4){bflo(sz.x), bfhi(sz.x), bflo(sz.y), bfhi(sz.y)});
            w.x = cvt_pk_bf16(ug[0] * (acc[pb][0] + bias) * zs[0], ug[1] * (acc[pb][1] + bias) * zs[1]);
            w.y = cvt_pk_bf16(ug[2] * (acc[pb][2] + bias) * zs[2], ug[3] * (acc[pb][3] + bias) * zs[3]);
            *gp = w;
        }
    }
    __syncthreads();
#pragma unroll
    for (int i = 0; i < 4; ++i) {
        const int idx = tid + 512 * i, r = idx >> 4, c16 = idx & 15;
        if (!dry) *(u32x4*)(P + (row0 + r) * ODD_IN + h * 128 + c16 * 8) = *(const LAS u32x4*)(GU + r * 272 + c16 * 16);
    }
    __syncthreads();
}


__device__ __forceinline__ void sgu_load(u32x4 (&gu)[4], u32x4 (&gv)[4], u32x4 (&sz)[4], float (&part)[4], const bf16_t* P, const float* ssv, int ch, int h, int tid) {
    const size_t row0 = (size_t)ch * 128;
#pragma unroll
    for (int i = 0; i < 4; ++i) {
        const int idx = tid + 512 * i, r = idx >> 4, c16 = idx & 15;
        const bf16_t* src = P + (row0 + r) * ODD_IN + h * 128 + c16 * 8;
        gu[i] = *(const u32x4*)src; gv[i] = *(const u32x4*)(src + 1024); sz[i] = *(const u32x4*)(src + 2048);
        part[i] = ssv[(row0 + r) * 16 + c16];
    }
}
__device__ __forceinline__ void sgu_run(LAS unsigned char* lds, bf16_t* P, const bf16_t* wsb, const float* bs, const float* sg, const float* ssv, int ch0, int cstep, int h, int tid, int lane, int wid, bool dry) {
    LAS unsigned char* GV = lds; LAS unsigned char* WT = lds + 36864; LAS unsigned char* GU = lds + 71680; LAS unsigned char* SZ = lds + 106496;
    u32x4 gu[4], gv[4], sz[4]; float part[4];
    if (ch0 < 384) sgu_load(gu, gv, sz, part, P, ssv, ch0, h, tid);
    bool first = true;
    const f32x4 sg0 = *(const f32x4*)(sg + h * 128 + (tid & 15) * 8), sg1 = *(const f32x4*)(sg + h * 128 + (tid & 15) * 8 + 4);
    for (int ch = ch0; ch < 384; ch += cstep) {
        const size_t row0 = (size_t)ch * 128;
#pragma unroll
        for (int i = 0; i < 4; ++i) {
            const int idx = tid + 512 * i, r = idx >> 4, c16 = idx & 15;
            float pt = part[i];
            pt += __shfl_xor(pt, 1); pt += __shfl_xor(pt, 2); pt += __shfl_xor(pt, 4); pt += __shfl_xor(pt, 8);
            const float rv = __builtin_amdgcn_rsqf(pt * (1.0f / 1024.0f) + EPS);
            const f32x4 g0 = sg0 * rv, g1 = sg1 * rv;
            u32x4 gn;
            gn.x = cvt_pk_bf16(bflo(gv[i].x) * g0[0], bfhi(gv[i].x) * g0[1]); gn.y = cvt_pk_bf16(bflo(gv[i].y) * g0[2], bfhi(gv[i].y) * g0[3]);
            gn.z = cvt_pk_bf16(bflo(gv[i].z) * g1[0], bfhi(gv[i].z) * g1[1]); gn.w = cvt_pk_bf16(bflo(gv[i].w) * g1[2], bfhi(gv[i].w) * g1[3]);
            *(LAS u32x4*)(GV + r * 288 + c16 * 16) = gn;
            *(LAS u32x4*)(GU + r * 272 + c16 * 16) = gu[i];
            *(LAS u32x4*)(SZ + r * 272 + c16 * 16) = sz[i];
            if (first) *(LAS u32x4*)(WT + r * 272 + c16 * 16) = *(const u32x4*)(wsb + ((size_t)(h * 128 + r) * 128 + c16 * 8));
        }
        first = false;
        __syncthreads();
        if (ch + cstep < 384) sgu_load(gu, gv, sz, part, P, ssv, ch + cstep, h, tid);
        {
            const int fr = lane & 15, fq = lane >> 4;
            bf16x8 af[4];
#pragma unroll
            for (int ks = 0; ks < 4; ++ks) {
                const LAS unsigned char* ap = GV + (32 * ks + 8 * fq + (fr >> 2)) * 288 + (16 * wid + 4 * (fr & 3)) * 2;
                const s16x4 a0 = vtr(ap), a1 = vtr(ap + 4 * 288);
                af[ks] = (bf16x8){a0[0], a0[1], a0[2], a0[3], a1[0], a1[1], a1[2], a1[3]};
            }
            f32x4 acc[8];
#pragma unroll
            for (int pb = 0; pb < 8; ++pb) acc[pb] = (f32x4){0.f, 0.f, 0.f, 0.f};
#pragma unroll
            for (int ks = 0; ks < 4; ++ks)
#pragma unroll
                for (int pb = 0; pb < 8; ++pb) {
                    const bf16x8 bfr = *(const LAS bf16x8*)(WT + (16 * pb + fr) * 272 + (32 * ks + 8 * fq) * 2);
                    acc[pb] = MFMA16(af[ks], bfr, acc[pb]);
                }
#pragma unroll
            for (int pb = 0; pb < 8; ++pb) {
                const int p = 16 * pb + fr; const float bias = bs[h * 128 + p];
                LAS u32x2* gp = (LAS u32x2*)(GU + p * 272 + (16 * wid + 4 * fq) * 2);
                const u32x2 gu2 = *gp, sz2 = *(const LAS u32x2*)(SZ + p * 272 + (16 * wid + 4 * fq) * 2);
                u32x2 w;
                const f32x4 ug = gelu4((f32x4){bflo(gu2.x), bfhi(gu2.x), bflo(gu2.y), bfhi(gu2.y)});
                const f32x4 zs = silu4((f32x4){bflo(sz2.x), bfhi(sz2.x), bflo(sz2.y), bfhi(sz2.y)});
                w.x = cvt_pk_bf16(ug[0] * (acc[pb][0] + bias) * zs[0], ug[1] * (acc[pb][1] + bias) * zs[1]);
                w.y = cvt_pk_bf16(ug[2] * (acc[pb][2] + bias) * zs[2], ug[3] * (acc[pb][3] + bias) * zs[3]);
                *gp = w;
            }
        }
        __syncthreads();
#pragma unroll
        for (int i = 0; i < 4; ++i) {
            const int idx = tid + 512 * i, r = idx >> 4, c16 = idx & 15;
            if (!dry) *(u32x4*)(P + (row0 + r) * ODD_IN + h * 128 + c16 * 8) = *(const LAS u32x4*)(GU + r * 272 + c16 * 16);
        }
        __syncthreads();
    }
}

#define XB_TMO      128
#define XB_XCNT(j)  (256  + 64 * (j))
#define XB_XSUB(j)  (1280 + 64 * (j))
#define XB_XGEN(j)  (2304 + 64 * (j))
#define XB_TOP      3328
#define XB_TOPGEN   3392
#define XCD_BAR_WORDS 3456
#define XB_SPIN_CAP (1u << 18)

__device__ __forceinline__ unsigned xb_ld(unsigned* p)              { return __hip_atomic_load(p, __ATOMIC_RELAXED, __HIP_MEMORY_SCOPE_AGENT); }
__device__ __forceinline__ unsigned xb_add(unsigned* p, unsigned v) { return __hip_atomic_fetch_add(p, v, __ATOMIC_RELAXED, __HIP_MEMORY_SCOPE_AGENT); }
__device__ __forceinline__ unsigned xb_xcc_id() { return (unsigned)__builtin_amdgcn_s_getreg((3 << 11) | 20) & 0xFu; }
#define XB_SPIN(cond, bar) do { unsigned _sp = 0; while (cond) { __builtin_amdgcn_s_sleep(1); \
    if ((++_sp & 255u) == 0u) { if (xb_ld(&(bar)[XB_TMO])) break; if (_sp > XB_SPIN_CAP) { atomicAdd(&(bar)[XB_TMO], 1u); break; } } } } while (0)

struct XcdBarrier {
    unsigned* bar; unsigned x;
    volatile LAS unsigned* st;
};

__device__ __forceinline__ XcdBarrier xcd_barrier_post(unsigned* bar, volatile LAS unsigned* st) {
    XcdBarrier b; b.bar = bar; b.x = xb_xcc_id(); b.st = st;
    if (threadIdx.x == 0) st[2] = xb_add(&bar[XB_XCNT(b.x)], 1u) + 1u;
    return b;
}
__device__ __forceinline__ void xcd_barrier_complete(unsigned* bar, unsigned x, unsigned& nloc, unsigned& nx) {
    const unsigned G = gridDim.x * gridDim.y * gridDim.z;
    unsigned sum, cnt, mine, sp = 0u;
    for (;;) {
        sum = 0u; cnt = 0u; mine = 0u;
#pragma unroll
        for (unsigned j = 0; j < 16; ++j) { const unsigned c = xb_ld(&bar[XB_XCNT(j)]); sum += c; cnt += (c > 0u) ? 1u : 0u; mine = (j == x) ? c : mine; }
        if (sum == G) break;
        __builtin_amdgcn_s_sleep(1);
        if ((++sp & 255u) == 0u) { if (xb_ld(&bar[XB_TMO])) break; if (sp > XB_SPIN_CAP) { atomicAdd(&bar[XB_TMO], 1u); break; } }
    }
    nloc = mine > 0u ? mine : 1u; nx = cnt > 0u ? cnt : 1u;
}

__device__ __forceinline__ void xcd_barrier(const XcdBarrier& b) {
    asm volatile("s_waitcnt vmcnt(0)" ::: "memory");
    __syncthreads();
    if (threadIdx.x == 0) {
        unsigned* bar = b.bar;
        __builtin_amdgcn_s_waitcnt(0);
        unsigned nloc = b.st[0], nx = b.st[1];
        if (nloc == 0u) { xcd_barrier_complete(bar, b.x, nloc, nx); b.st[0] = nloc; b.st[1] = nx; }
        const unsigned old = xb_add(&bar[XB_XSUB(b.x)], 1u);
        const unsigned gen = old / nloc;
        if (old + 1u == (gen + 1u) * nloc) {
            __builtin_amdgcn_fence(__ATOMIC_RELEASE, "agent");
            asm volatile("s_waitcnt vmcnt(0)" ::: "memory");
            const unsigned og = xb_add(&bar[XB_TOP], 1u);
            const unsigned tg = og / nx;
            if (og + 1u == (tg + 1u) * nx) xb_add(&bar[XB_TOPGEN], 1u);
            else XB_SPIN(xb_ld(&bar[XB_TOPGEN]) == tg, bar);
            __builtin_amdgcn_fence(__ATOMIC_ACQUIRE, "agent");
            xb_add(&bar[XB_XGEN(b.x)], 1u);
            asm volatile("s_waitcnt vmcnt(0)" ::: "memory");
        } else {
            XB_SPIN(xb_ld(&bar[XB_XGEN(b.x)]) == gen, bar);
            __builtin_amdgcn_fence(__ATOMIC_ACQUIRE, "agent");
            asm volatile("s_waitcnt vmcnt(0)" ::: "memory");
        }
    }
    __syncthreads();
}

#ifdef DIAG
#define DG(k) (DIAG == (k))
#else
#define DG(k) true
#endif
__global__ void __launch_bounds__(512, 2) fwd_kernel(Args a) {
    extern __shared__ __attribute__((aligned(16))) unsigned char lds_raw[];
    LAS unsigned char* lds = (LAS unsigned char*)lds_raw;
    const int wid = __builtin_amdgcn_readfirstlane(threadIdx.x >> 6);
    const int G = gridDim.x, bx0 = blockIdx.x;
    int bx = bx0;
    unsigned char* ws = a.ws;
    bf16_t* P = (bf16_t*)(ws + WS_P); bf16_t* XB = (bf16_t*)(ws + WS_XB);
    float* SS = (float*)(ws + WS_SS); float* SSV = (float*)(ws + WS_SSV);
    const float* rope = (const float*)(ws + WS_ROPE);
    if (threadIdx.x < 4) ((LAS unsigned*)(lds + BARW_OFF))[threadIdx.x] = 0u;
    __syncthreads();
    XcdBarrier xbar = xcd_barrier_post((unsigned*)(ws + WS_BAR), (volatile LAS unsigned*)(lds + BARW_OFF));
    for (int ph = a.ph_lo; ph < a.ph_hi; ++ph) {
        if (ph > 0 && ((ph - 1) & 3) == 1 && (((ph - 1) >> 2) & 1)) continue;
#ifdef PROBE_KIND
        const int kind = (ph == 0) ? 0 : ((((ph - 1) & 3) == 2) ? ((((ph - 1) >> 2) & 1) ? 3 : 2) : 1);
        const int nrep = (kind == PROBE_KIND && a.ph_lo == 0) ? 2 : 1;
#else
        const int nrep = 1;
#endif
        for (int rep = 0; rep < nrep; ++rep) {
        const bool dry = (rep + 1 < nrep);
        if (rep) { __syncthreads(); cg::this_grid().sync(); }
        int tid = threadIdx.x; asm volatile("" : "+v"(tid));
        const int lane = tid & 63;
        if (ph == 0) {
            if (DG(0)) prologue(a, lds, tid, lane, wid);
            __syncthreads();
        } else {
            const int layer = (ph - 1) >> 2, sub4 = (ph - 1) & 3, j = layer >> 1; const bool even = (layer & 1) == 0;
            const int sub = (sub4 == 0) ? 0 : (sub4 == 1 ? 3 : sub4 - 1);
            if (sub == 3) {
                kprep_phase(P, a.in[7] + j * 64, rope, tid, bx, G);
            } else if (sub == 0) {
                if (even) {
                    pg8::Gemm g{XB, (const bf16_t*)(ws + WS_WINE) + (size_t)j * 2304 * 1024, MTOK, EVEN_IN, 1024, 1024, 0};
                    pg8::StaticOrder S; S.init(MTOK, EVEN_IN, G, bx);
                    pg8::EpiEvenIn E{P, SS, (LAS float*)(lds + RST_OFF)};
                    if (DG(1)) pg8::gemm_phase(lds, g, S, E, tid);
                } else {
                    pg8::Gemm g{XB, (const bf16_t*)(ws + WS_WINO) + (size_t)j * 3072 * 1024, MTOK, ODD_IN, 1024, 1024, 0};
                    pg8::StaticOrder S; S.init(MTOK, ODD_IN, G, bx);
                    pg8::EpiOddIn E{P, SS, SSV, (LAS float*)(lds + RST_OFF)};
                    if (DG(2)) pg8::gemm_phase(lds, g, S, E, tid);
                }
            } else if (sub == 1) {
                if (even) {
                    const int x = bx & 7, y = bx >> 3, gpx = G >> 3;
                    const bool xcdmap = (G % 8 == 0);
                    for (int i = 0;; ++i) {
                        const int v = xcdmap ? ((i * 8 + x) * gpx + y) : (i * G + bx);
                        if (v >= 1536) break;
                        const int grp = v >> 6, w = v & 63;
                        if (DG(3)) attn_unit(lds, P, a.in[6] + j * 64, rope, grp >> 1, (grp & 1) * 4 + (w >> 4), w & 15, lane, wid, dry);
                    }
                    const bf16_t* pwT = (const bf16_t*)(ws + WS_POOLW) + (size_t)j * 4 * 128 * 128;
                    if (DG(4)) pool_run(lds, P, pwT, a.in[5] + j * 512, bx, G, tid, lane, wid, dry);
                } else {
                    const bf16_t* wsb = (const bf16_t*)(ws + WS_WSB) + (size_t)j * 8 * 128 * 128;
                    int hprev = -1;
                    if (G % 8 == 0) {
                        const int h = bx & 7;
                        if (DG(5)) sgu_run(lds, P, wsb, a.in[13] + j * 1024, a.in[11] + j * 1024, SSV, bx >> 3, G >> 3, h, tid, lane, wid, dry);
                    } else {
                        for (int it = bx; it < 3072; it += G) { const int h = it & 7; if (DG(5)) sgu_item(lds, P, wsb, a.in[13] + j * 1024, a.in[11] + j * 1024, SSV, it >> 3, h, h != hprev, tid, lane, wid, dry); hprev = h; }
                    }
                }
            } else {
                if (even) {
                    pg8::Gemm g{P + 512, (const bf16_t*)(ws + WS_WOUTE) + (size_t)j * 1024 * 1024, MTOK, 1024, 1024, EVEN_IN, 1536};
                    pg8::StaticOrder S; S.init(MTOK, 1024, G, bx);
                    pg8::EpiOut E{a.out, layer == 0 ? a.in[0] : a.out, layer == 0 ? a.in[1] - (size_t)MPROMPT * DM : a.out, XB, SS, dry, layer == 3};
                    if (DG(6)) pg8::gemm_phase(lds, g, S, E, tid);
                } else {
                    pg8::Gemm g{P, (const bf16_t*)(ws + WS_WOUTO) + (size_t)j * 1024 * 1024, MTOK, 1024, 1024, ODD_IN, 0};
                    pg8::StaticOrder S; S.init(MTOK, 1024, G, bx);
                    pg8::EpiOut E{a.out, layer == 0 ? a.in[0] : a.out, layer == 0 ? a.in[1] - (size_t)MPROMPT * DM : a.out, XB, SS, dry, layer == 3};
                    if (DG(6)) pg8::gemm_phase(lds, g, S, E, tid);
                }
            }
        }
        }
        if (ph + 1 < a.ph_hi) { if (a.ph_hi > NPHASE) cg::this_grid().sync(); else xcd_barrier(xbar); }
        if (ph == a.ph_lo && ph + 1 < a.ph_hi) {
            volatile LAS unsigned* st = (volatile LAS unsigned*)(lds + BARW_OFF);
            if (threadIdx.x == 0) {
                unsigned* bar = (unsigned*)(ws + WS_BAR); bool ok = (G % 8 == 0) && (xbar.x < 8u);
                for (unsigned jx = 0; jx < 8; ++jx) ok = ok && (xb_ld(&bar[XB_XCNT(jx)]) == (unsigned)(G / 8));
                st[3] = ok ? 1u : 0u;
            }
            __syncthreads();
            if (st[3]) bx = __builtin_amdgcn_readfirstlane((int)xbar.x + 8 * (int)(st[2] - 1u));
        }
    }
}

extern "C" void kernel_launch(void* const* d_in, const int* in_sizes, int n_in, void* d_out, int out_size, void* d_ws, size_t ws_size, hipStream_t stream) {
    static int grid = 0;
    if (grid == 0) {
        if (n_in != 15 || out_size != MTOK * DM || ws_size < WS_END) { fprintf(stderr, "kernel_launch: unexpected shapes (n_in %d out %d ws %zu need %zu)\n", n_in, out_size, ws_size, (size_t)WS_END); grid = -1; return; }
        int dev = 0, cus = 0, per_cu = 0;
        (void)hipGetDevice(&dev);
        (void)hipDeviceGetAttribute(&cus, hipDeviceAttributeMultiprocessorCount, dev);
        if (hipFuncSetAttribute((const void*)fwd_kernel, hipFuncAttributeMaxDynamicSharedMemorySize, LDS_BYTES) != hipSuccess) { fprintf(stderr, "kernel_launch: hipFuncSetAttribute failed\n"); grid = -1; return; }
        if (hipOccupancyMaxActiveBlocksPerMultiprocessor(&per_cu, (const void*)fwd_kernel, 512, LDS_BYTES) != hipSuccess || per_cu < 1) { fprintf(stderr, "kernel_launch: occupancy query gave %d\n", per_cu); per_cu = 1; }
        (void)hipGetLastError();
        grid = cus * per_cu;
        if (grid <= 0) grid = 256;
    }
    if (grid < 0) return;
    (void)hipMemsetAsync((char*)d_ws + WS_BAR, 0, 16384, stream);
    Args a{};
    for (int i = 0; i < 15; ++i) a.in[i] = (const float*)d_in[i];
    a.out = (float*)d_out; a.ws = (unsigned char*)d_ws;
#if N_LAUNCH_MODE == 1
    a.ph_lo = 0; a.ph_hi = NPHASE;
    void* args[] = {&a};
    hipError_t e = hipLaunchCooperativeKernel((const void*)fwd_kernel, dim3(grid), dim3(512), args, LDS_BYTES, stream);
    if (e != hipSuccess) fprintf(stderr, "cooperative launch failed: %s (grid %d)\n", hipGetErrorString(e), grid);
#else
    for (int ph = 0; ph < NPHASE; ++ph) {
        a.ph_lo = ph; a.ph_hi = ph + 1;
        hipLaunchKernelGGL(fwd_kernel, dim3(grid), dim3(512), LDS_BYTES, stream, a);
    }
#endif
}
```
